# Optimizing an MI355X kernel written in HIP

```python
import jax, jax.numpy as jnp
from jax import lax
import numpy as np

D_MODEL = 1024
BATCH = 4
SEQ = 8192
DEPTH = 2

D_FF = 2816
D_MIX = D_MODEL
POOL_CH = D_MIX // 2
POOL_WINDOWS = (2, 4, 8, 16)
POOL_GROUPS = len(POOL_WINDOWS)
POOL_GC = POOL_CH // POOL_GROUPS
CONV_CH = D_MIX - POOL_CH
CONV_WIDTH = 31
AB_IN = POOL_CH + 2 * CONV_CH
SGU_CH = D_MIX
SGU_HEADS = 8
SGU_HC = SGU_CH // SGU_HEADS
CHUNK = 128
N_EVEN = (DEPTH + 1) // 2
N_ODD = DEPTH // 2
EPS = 1e-6

kernel_name = "hybrid_pool_conv_sgu_macaron"


def rms_norm(x, g):
    xf = x.astype(jnp.float32)
    y = xf * lax.rsqrt(jnp.mean(xf * xf, axis=-1, keepdims=True) + EPS)
    return (y * g.astype(jnp.float32)).astype(x.dtype)


def layer_norm(x, g, b):
    xf = x.astype(jnp.float32)
    mu = jnp.mean(xf, axis=-1, keepdims=True)
    var = jnp.mean(jnp.square(xf - mu), axis=-1, keepdims=True)
    y = (xf - mu) * lax.rsqrt(var + EPS)
    return (y * g.astype(jnp.float32) + b.astype(jnp.float32)).astype(x.dtype)


def swiglu_ffn(x, w_in, w_out):
    gate, up = jnp.split(x @ w_in, 2, axis=-1)
    return (jax.nn.silu(gate) * up) @ w_out


def pool_mixer(u, w, b, scale):
    bsz, t_len, _ = u.shape
    csum = jnp.cumsum(u.astype(jnp.float32), axis=1)
    pos = jnp.arange(t_len, dtype=jnp.int32)
    means = []
    for g, win in enumerate(POOL_WINDOWS):
        cg = csum[..., g * POOL_GC:(g + 1) * POOL_GC]
        shifted = jnp.pad(cg[:, :t_len - win], ((0, 0), (win, 0), (0, 0)))
        count = jnp.minimum(pos + 1, win).astype(jnp.float32)[None, :, None]
        means.append((cg - shifted) / count)
    pooled = jnp.concatenate(means, axis=-1).astype(u.dtype) - u
    pooled = pooled.reshape(bsz, t_len, POOL_GROUPS, POOL_GC)
    mixed = jnp.einsum('btgc,gcd->btgd', pooled, w) + b
    return mixed.reshape(bsz, t_len, POOL_CH) * scale


def conv_module(h, conv_w, conv_b, ln_g, ln_b):
    a, gate = jnp.split(h, 2, axis=-1)
    g = a * jax.nn.sigmoid(gate)
    y = lax.conv_general_dilated(
        g, conv_w[:, None, :], window_strides=(1,), padding=((CONV_WIDTH - 1, 0),),
        dimension_numbers=('NWC', 'WIO', 'NWC'), feature_group_count=CONV_CH) + conv_b
    return jax.nn.silu(layer_norm(y, ln_g, ln_b))


def pool_conv_mixer(xn, w_in, pool_w, pool_b, pool_scale, conv_w, conv_b, ln_g, ln_b, w_out):
    h = xn @ w_in
    ya = pool_mixer(h[..., :POOL_CH], pool_w, pool_b, pool_scale)
    yb = conv_module(h[..., POOL_CH:], conv_w, conv_b, ln_g, ln_b)
    return jnp.concatenate([ya, yb], axis=-1) @ w_out


def sgu_mixer(xn, w_in, ln_g, ln_b, w_s, b_s, w_out):
    bsz, t_len, _ = xn.shape
    z = jax.nn.gelu(xn @ w_in, approximate=False)
    u, v = jnp.split(z, 2, axis=-1)
    v = layer_norm(v, ln_g, ln_b)
    v = v.reshape(bsz, t_len // CHUNK, CHUNK, SGU_HEADS, SGU_HC)
    mask = jnp.tril(jnp.ones((CHUNK, CHUNK), dtype=w_s.dtype))
    w_masked = w_s * mask
    v = jnp.einsum('hst,bnthc->bnshc', w_masked, v) + b_s.T[None, None, :, :, None]
    v = v.reshape(bsz, t_len, SGU_CH)
    return (u * v) @ w_out


def setup_inputs(seed: int = 0) -> dict:
    key = jax.random.key(seed)
    ks = iter(jax.random.split(key, 32))

    def nrm(shape, scale):
        return jax.random.normal(next(ks), shape, jnp.float32) * scale

    def gain(shape):
        return 1.0 + nrm(shape, 0.05)

    return {
        "x": nrm((BATCH, SEQ, D_MODEL), 1.0),
        "ffn1_norm": gain((DEPTH, D_MODEL)),
        "ffn1_w_in": nrm((DEPTH, D_MODEL, 2 * D_FF), D_MODEL ** -0.5),
        "ffn1_w_out": nrm((DEPTH, D_FF, D_MODEL), D_FF ** -0.5),
        "mix_norm": gain((DEPTH, D_MODEL)),
        "ffn2_norm": gain((DEPTH, D_MODEL)),
        "ffn2_w_in": nrm((DEPTH, D_MODEL, 2 * D_FF), D_MODEL ** -0.5),
        "ffn2_w_out": nrm((DEPTH, D_FF, D_MODEL), D_FF ** -0.5),
        "ab_w_in": nrm((N_EVEN, D_MODEL, AB_IN), D_MODEL ** -0.5),
        "pool_w": nrm((N_EVEN, POOL_GROUPS, POOL_GC, POOL_GC), POOL_GC ** -0.5),
        "pool_b": nrm((N_EVEN, POOL_GROUPS, POOL_GC), 0.02),
        "pool_scale": 0.5 + nrm((N_EVEN, POOL_CH), 0.05),
        "conv_w": nrm((N_EVEN, CONV_WIDTH, CONV_CH), CONV_WIDTH ** -0.5),
        "conv_b": nrm((N_EVEN, CONV_CH), 0.02),
        "conv_ln_g": gain((N_EVEN, CONV_CH)),
        "conv_ln_b": nrm((N_EVEN, CONV_CH), 0.02),
        "ab_w_out": nrm((N_EVEN, D_MIX, D_MODEL), D_MIX ** -0.5),
        "sgu_w_in": nrm((N_ODD, D_MODEL, 2 * SGU_CH), D_MODEL ** -0.5),
        "sgu_ln_g": gain((N_ODD, SGU_CH)),
        "sgu_ln_b": nrm((N_ODD, SGU_CH), 0.02),
        "sgu_w": nrm((N_ODD, SGU_HEADS, CHUNK, CHUNK), CHUNK ** -0.5),
        "sgu_b": 1.0 + nrm((N_ODD, SGU_HEADS, CHUNK), 0.05),
        "sgu_w_out": nrm((N_ODD, SGU_CH, D_MODEL), SGU_CH ** -0.5),
        "final_norm": gain((D_MODEL,)),
    }


def reference(x, ffn1_norm, ffn1_w_in, ffn1_w_out, mix_norm, ffn2_norm, ffn2_w_in, ffn2_w_out,
              ab_w_in, pool_w, pool_b, pool_scale, conv_w, conv_b, conv_ln_g, conv_ln_b, ab_w_out,
              sgu_w_in, sgu_ln_g, sgu_ln_b, sgu_w, sgu_b, sgu_w_out, final_norm):
    for i in range(DEPTH):
        x = x + 0.5 * swiglu_ffn(rms_norm(x, ffn1_norm[i]), ffn1_w_in[i], ffn1_w_out[i])
        xn = rms_norm(x, mix_norm[i])
        if i % 2 == 0:
            j = i // 2
            y = pool_conv_mixer(xn, ab_w_in[j], pool_w[j], pool_b[j], pool_scale[j],
                                conv_w[j], conv_b[j], conv_ln_g[j], conv_ln_b[j], ab_w_out[j])
        else:
            j = i // 2
            y = sgu_mixer(xn, sgu_w_in[j], sgu_ln_g[j], sgu_ln_b[j], sgu_w[j], sgu_b[j], sgu_w_out[j])
        x = x + y
        x = x + 0.5 * swiglu_ffn(rms_norm(x, ffn2_norm[i]), ffn2_w_in[i], ffn2_w_out[i])
    return rms_norm(x, final_norm)
```

```cpp
#include <hip/hip_runtime.h>
#include <hip/hip_cooperative_groups.h>
#include <cstdio>
#include <cstdint>
namespace pg8 {
#define PG8_LAS __attribute__((address_space(3)))
typedef unsigned short bf16_t;
typedef short bf16x8 __attribute__((ext_vector_type(8)));
typedef float f32x4 __attribute__((ext_vector_type(4)));
typedef unsigned u32x4 __attribute__((ext_vector_type(4)));
constexpr int BM = 256, BK = 64, HALF = 128, HTB = HALF * BK * 2  , STAGE_BYTES = 8 * HTB, NXCD = 8, WGM = 8;

__host__ __device__ __forceinline__ int lds_byte(int r, int c) { const int st = (r >> 4) * 2 + (c >> 5), rr = r & 15, cc = c & 31, ob = rr * 64 + cc * 2; return st * 1024 + (ob ^ (((ob >> 9) & 1) << 5)); }
__host__ __device__ __forceinline__ void stage_rc(int b, int& R, int& C) { const int st = b / 1024, sb = b % 1024, swz = sb ^ (((sb >> 9) & 1) << 5); R = (st >> 1) * 16 + swz / 64; C = (st & 1) * 32 + (swz % 64) / 2; }
__host__ __device__ __forceinline__ int perm32(int rho) { const int n = rho >> 4, i = rho & 15; return 8 * (i >> 2) + 4 * n + (i & 3); }

struct Unit { int pm, pn; };
struct Gemm { const bf16_t* A; const bf16_t* Bt; int M, N, K; };

struct StaticOrder {
    int nM, nN, nwg, G, c;
    __host__ __device__ void init(int M, int N, int G_, int c_) { nM = M / BM; nN = N / BM; nwg = nM * nN; G = G_; c = c_; }
    __host__ __device__ bool next(int i, Unit& u) const {
        const long L = (long)i * G + c; if (L >= nwg) return false;
        int wgid = (int)L; { const int q = nwg / NXCD, r = nwg % NXCD, xcd = wgid % NXCD, off = wgid / NXCD; wgid = (xcd < r ? xcd * (q + 1) : r * (q + 1) + (xcd - r) * q) + off; }
        const int nig = WGM * nN, gid = wgid / nig, fm = gid * WGM, gsz = (nM - fm) < WGM ? (nM - fm) : WGM;
        u.pm = fm + ((wgid % nig) % gsz); u.pn = (wgid % nig) / gsz; return true;
    }
    __device__ __forceinline__ void a_ready(const Unit&) const {}
    __device__ __forceinline__ void done(const Unit&) const {}
};

__device__ __forceinline__ unsigned cvt_pk_bf16(float lo, float hi) { unsigned r; asm volatile("v_cvt_pk_bf16_f32 %0, %1, %2" : "=v"(r) : "v"(lo), "v"(hi)); return r; }
typedef float f32x2 __attribute__((ext_vector_type(2)));
__device__ __forceinline__ f32x2 gelu_pk(f32x2 v) {
    const f32x2 av = __builtin_elementwise_abs(v), d = av * 0.2316418882f + 1.0f;
    f32x2 t; t.x = __builtin_amdgcn_rcpf(d.x); t.y = __builtin_amdgcn_rcpf(d.y);
    f32x2 q = t * 0.5307027145f + (-0.7265760135f); q = q * t + 0.7107068705f; q = q * t + (-0.142248368f); q = q * t + 0.127414796f; q = q * t;
    const f32x2 s = (v * v) * (-0.72134752044f);
    f32x2 e; e.x = __builtin_amdgcn_exp2f(s.x); e.y = __builtin_amdgcn_exp2f(s.y);
    const f32x2 m = v * (q * e), r = v - m;
    f32x2 o; o.x = v.x < 0.f ? m.x : r.x; o.y = v.y < 0.f ? m.y : r.y; return o;
}
constexpr float RMS_EPS = 1e-6f;
typedef unsigned u32x2 __attribute__((ext_vector_type(2)));
constexpr int RSTD_OFF = 131072 + 1024;
__device__ __forceinline__ float row_rstd(PG8_LAS unsigned char* lds, int ui, int r) { return *(const PG8_LAS float*)(lds + RSTD_OFF + (ui * 256 + r) * 4); }
__device__ __forceinline__ float silu_f(float x) { return x * __builtin_amdgcn_rcpf(1.0f + __builtin_amdgcn_exp2f(x * -1.44269504089f)); }
__device__ __forceinline__ float sigm_f(float x) { return __builtin_amdgcn_rcpf(1.0f + __builtin_amdgcn_exp2f(x * -1.44269504089f)); }
__device__ __forceinline__ u32x4 pack8(const f32x4& a, const f32x4& b) { u32x4 w; w.x = cvt_pk_bf16(a[0], a[1]); w.y = cvt_pk_bf16(a[2], a[3]); w.z = cvt_pk_bf16(b[0], b[1]); w.w = cvt_pk_bf16(b[2], b[3]); return w; }

struct EpiSwiglu {
    static constexpr bool PERM = true, AFTER_DRAIN = false;
    bf16_t* H; int ldh; PG8_LAS unsigned char* lds; int skip;
    __device__ __forceinline__ void operator()(const f32x4 (&acc)[2][2][4][2], const Unit& u, int ui, int wr, int wc, int fr, int fq) const {
        asm volatile("" : "+v"(fr), "+v"(fq));
        if (skip) return;
        const int row0 = u.pm * BM + wr * 64 + fr, col0 = u.pn * HALF + wc * 32 + 8 * fq;
        float rs[2][4];
#pragma unroll
        for (int ai = 0; ai < 2; ++ai)
#pragma unroll
            for (int m = 0; m < 4; ++m) rs[ai][m] = row_rstd(lds, ui, ai * HALF + wr * 64 + m * 16 + fr);
#pragma unroll
        for (int ai = 0; ai < 2; ++ai)
#pragma unroll
            for (int m = 0; m < 4; ++m) { const float r = rs[ai][m]; const int row = row0 + ai * HALF + m * 16;
                const float c1 = r * -1.44269504089f, r2 = r * r; u32x4 w;
#pragma unroll
                for (int n = 0; n < 2; ++n)
#pragma unroll
                    for (int p = 0; p < 2; ++p) { const f32x2 g = (f32x2){acc[ai][0][m][n][2 * p], acc[ai][0][m][n][2 * p + 1]}, uu = (f32x2){acc[ai][1][m][n][2 * p], acc[ai][1][m][n][2 * p + 1]};
                        const f32x2 t = g * c1; f32x2 d; d.x = __builtin_amdgcn_exp2f(t.x); d.y = __builtin_amdgcn_exp2f(t.y); d = d + 1.0f;
                        f32x2 q; q.x = __builtin_amdgcn_rcpf(d.x); q.y = __builtin_amdgcn_rcpf(d.y);
                        const f32x2 hh = (g * uu) * (q * r2); w[2 * n + p] = cvt_pk_bf16(hh.x, hh.y); }
                __builtin_nontemporal_store(w, (u32x4*)(H + (size_t)row * ldh + col0)); }
    }
};

template <bool HAS_BIAS> struct EpiResid {
    static constexpr bool PERM = true, AFTER_DRAIN = false;
    const float* basef; float* outf; bf16_t* xb; float* ssp; const float* bias; float alpha;
    __device__ __forceinline__ void operator()(const f32x4 (&acc)[2][2][4][2], const Unit& u, int ui, int wr, int wc, int fr, int fq) const {
        asm volatile("" : "+v"(fr), "+v"(fq));
        const int row0 = u.pm * BM + wr * 64 + fr, col0 = u.pn * BM + wc * 32 + 8 * fq;
        f32x4 bv[2][2];
#pragma unroll
        for (int bj = 0; bj < 2; ++bj)
#pragma unroll
            for (int n = 0; n < 2; ++n) bv[bj][n] = HAS_BIAS ? *(const f32x4*)(bias + col0 + bj * HALF + 4 * n) : (f32x4){0.f, 0.f, 0.f, 0.f};
#pragma unroll
        for (int ai = 0; ai < 2; ++ai)
#pragma unroll
            for (int m = 0; m < 4; ++m) { const int row = row0 + ai * HALF + m * 16; const size_t off = (size_t)row * 1024 + col0; float q = 0.f;
                f32x4 v[2][2];
                if (basef) {
#pragma unroll
                    for (int bj = 0; bj < 2; ++bj) { v[bj][0] = *(const f32x4*)(basef + off + bj * HALF); v[bj][1] = *(const f32x4*)(basef + off + bj * HALF + 4); }
                } else {
#pragma unroll
                    for (int bj = 0; bj < 2; ++bj) { const u32x4 raw = *(const u32x4*)(xb + off + bj * HALF);
                        v[bj][0] = (f32x4){__builtin_bit_cast(float, raw.x << 16), __builtin_bit_cast(float, raw.x & 0xffff0000u), __builtin_bit_cast(float, raw.y << 16), __builtin_bit_cast(float, raw.y & 0xffff0000u)};
                        v[bj][1] = (f32x4){__builtin_bit_cast(float, raw.z << 16), __builtin_bit_cast(float, raw.z & 0xffff0000u), __builtin_bit_cast(float, raw.w << 16), __builtin_bit_cast(float, raw.w & 0xffff0000u)}; }
                }
#pragma unroll
                for (int bj = 0; bj < 2; ++bj) {
                    f32x4 v0 = v[bj][0] + acc[ai][bj][m][0] * alpha, v1 = v[bj][1] + acc[ai][bj][m][1] * alpha;
                    if (HAS_BIAS) { v0 += bv[bj][0]; v1 += bv[bj][1]; }
                    if (outf) { *(f32x4*)(outf + off + bj * HALF) = v0; *(f32x4*)(outf + off + bj * HALF + 4) = v1; }
                    else *(u32x4*)(xb + off + bj * HALF) = pack8(v0, v1);
                    q += (v0[0] * v0[0] + v0[1] * v0[1]) + (v0[2] * v0[2] + v0[3] * v0[3]) + (v1[0] * v1[0] + v1[1] * v1[1]) + (v1[2] * v1[2] + v1[3] * v1[3]); }
                q += __shfl_xor(q, 16); q += __shfl_xor(q, 32);
                if (fq == 0) ssp[(size_t)row * 16 + u.pn * 4 + wc] = q;
                if (m == 3) asm volatile("" ::: "memory"); }
    }
};

struct EpiAb {
    static constexpr bool PERM = true, AFTER_DRAIN = false;
    bf16_t* UG; PG8_LAS unsigned char* lds;
    __device__ __forceinline__ void operator()(const f32x4 (&acc)[2][2][4][2], const Unit& u, int ui, int wr, int wc, int fr, int fq) const {
        asm volatile("" : "+v"(fr), "+v"(fq));
        const int row0 = u.pm * BM + wr * 64 + fr, cw = wc * 32 + 8 * fq;
        float rs[2][4];
#pragma unroll
        for (int ai = 0; ai < 2; ++ai)
#pragma unroll
            for (int m = 0; m < 4; ++m) rs[ai][m] = row_rstd(lds, ui, ai * HALF + wr * 64 + m * 16 + fr);
        if (u.pn < 2) {
#pragma unroll
            for (int ai = 0; ai < 2; ++ai)
#pragma unroll
                for (int m = 0; m < 4; ++m) { const float r = rs[ai][m]; bf16_t* rowp = UG + (size_t)(row0 + ai * HALF + m * 16) * 1024 + u.pn * BM + cw;
#pragma unroll
                    for (int bj = 0; bj < 2; ++bj) *(u32x4*)(rowp + bj * HALF) = pack8(acc[ai][bj][m][0] * r, acc[ai][bj][m][1] * r); }
        } else {
#pragma unroll
            for (int ai = 0; ai < 2; ++ai)
#pragma unroll
                for (int m = 0; m < 4; ++m) { const float r = rs[ai][m]; bf16_t* rowp = UG + (size_t)(row0 + ai * HALF + m * 16) * 1024 + 512 + (u.pn - 2) * HALF + cw;
                    const float c1 = r * -1.44269504089f; u32x4 w;
#pragma unroll
                    for (int n = 0; n < 2; ++n)
#pragma unroll
                        for (int p = 0; p < 2; ++p) { const f32x2 av = (f32x2){acc[ai][0][m][n][2 * p], acc[ai][0][m][n][2 * p + 1]}, gt = (f32x2){acc[ai][1][m][n][2 * p], acc[ai][1][m][n][2 * p + 1]};
                            const f32x2 t = gt * c1; f32x2 d; d.x = __builtin_amdgcn_exp2f(t.x); d.y = __builtin_amdgcn_exp2f(t.y); d = d + 1.0f;
                            f32x2 q; q.x = __builtin_amdgcn_rcpf(d.x); q.y = __builtin_amdgcn_rcpf(d.y);
                            const f32x2 hh = av * (q * r); w[2 * n + p] = cvt_pk_bf16(hh.x, hh.y); }
                    *(u32x4*)rowp = w; }
        }
    }
};

struct EpiSgu {
    static constexpr bool PERM = true, AFTER_DRAIN = false;
    bf16_t* Z; PG8_LAS unsigned char* lds; f32x2* vst;
    __device__ __forceinline__ void operator()(const f32x4 (&acc)[2][2][4][2], const Unit& u, int ui, int wr, int wc, int fr, int fq) const {
        asm volatile("" : "+v"(fr), "+v"(fq));
        const int row0 = u.pm * BM + wr * 64 + fr, col0 = u.pn * BM + wc * 32 + 8 * fq;
        float rs[2][4];
#pragma unroll
        for (int ai = 0; ai < 2; ++ai)
#pragma unroll
            for (int m = 0; m < 4; ++m) rs[ai][m] = row_rstd(lds, ui, ai * HALF + wr * 64 + m * 16 + fr);
#pragma unroll
        for (int ai = 0; ai < 2; ++ai)
#pragma unroll
            for (int m = 0; m < 4; ++m) { const float r = rs[ai][m]; const int row = row0 + ai * HALF + m * 16; bf16_t* rowp = Z + (size_t)row * 2048 + col0; float s1 = 0.f, s2 = 0.f;
#pragma unroll
                for (int bj = 0; bj < 2; ++bj) { const f32x4 v0 = acc[ai][bj][m][0] * r, v1 = acc[ai][bj][m][1] * r;
                    const f32x2 a = gelu_pk((f32x2){v0[0], v0[1]}), b = gelu_pk((f32x2){v0[2], v0[3]}), c = gelu_pk((f32x2){v1[0], v1[1]}), d = gelu_pk((f32x2){v1[2], v1[3]});
                    const f32x4 z0 = (f32x4){a.x, a.y, b.x, b.y}, z1 = (f32x4){c.x, c.y, d.x, d.y};
                    *(u32x4*)(rowp + bj * HALF) = pack8(z0, z1);
                    s1 += (z0[0] + z0[1]) + (z0[2] + z0[3]) + (z1[0] + z1[1]) + (z1[2] + z1[3]);
                    s2 += (z0[0] * z0[0] + z0[1] * z0[1]) + (z0[2] * z0[2] + z0[3] * z0[3]) + (z1[0] * z1[0] + z1[1] * z1[1]) + (z1[2] * z1[2] + z1[3] * z1[3]); }
                if (u.pn >= 4) { s1 += __shfl_xor(s1, 16); s1 += __shfl_xor(s1, 32); s2 += __shfl_xor(s2, 16); s2 += __shfl_xor(s2, 32);
                    if (fq == 0) vst[(size_t)row * 16 + (u.pn - 4) * 4 + wc] = (f32x2){s1, s2}; } }
    }
};


struct EpiNull {
    static constexpr bool PERM = true, AFTER_DRAIN = false;
    float* sink;
    __device__ __forceinline__ void operator()(const f32x4 (&acc)[2][2][4][2], const Unit& u, int ui, int wr, int wc, int fr, int fq) const {
        float s = 0.f;
#pragma unroll
        for (int ai = 0; ai < 2; ++ai)
#pragma unroll
            for (int bj = 0; bj < 2; ++bj)
#pragma unroll
                for (int m = 0; m < 4; ++m)
#pragma unroll
                    for (int n = 0; n < 2; ++n) s += acc[ai][bj][m][n][0] + acc[ai][bj][m][n][1] + acc[ai][bj][m][n][2] + acc[ai][bj][m][n][3];
        if (s == 1.2345678e30f) sink[0] = s;
    }
};
template <class Epi, class Sched, bool ALIGN_EPI = false, bool SP2 = false>
__device__ __forceinline__ void gemm_phase(PG8_LAS unsigned char* lds, const Gemm g, const Sched& S, const Epi& E) {
    int tid_ = threadIdx.x; asm volatile("" : "+v"(tid_));
    const int tid = tid_, wid = __builtin_amdgcn_readfirstlane(tid >> 6), lane = tid & 63, wr = wid >> 2, wc = wid & 3, fr = lane & 15, fq = lane >> 4;
    const int K = g.K, nt = K / BK;
    unsigned voffA[2], voffB[2];
#pragma unroll
    for (int i = 0; i < 2; ++i) { int R, C; stage_rc(tid * 16 + i * 8192, R, C); const int Rb = Epi::PERM ? ((R & ~31) + perm32(R & 31)) : R;
        voffA[i] = (unsigned)(R * K + C) * 2u; voffB[i] = (unsigned)(Rb * K + C) * 2u; }
    const size_t kstep = (size_t)(BK * 2);
    const size_t hstep = (size_t)HALF * K * 2;
    const size_t tstep = 2 * hstep;
    const unsigned ldsw = (unsigned)wid * 1024u;
    const int aoff = lds_byte(wr * 64 + fr, fq * 8), boff = lds_byte(wc * 32 + fr, fq * 8);
#define PG8_SA(b, h) (((b) * 2 + (h)) * HTB)
#define PG8_SB(b, h) ((4 + (b) * 2 + (h)) * HTB)
#define PG8_STAGE(bufoff, gbase, voff) do { _Pragma("unroll") for (int _i = 0; _i < 2; ++_i) \
        __builtin_amdgcn_global_load_lds((const unsigned*)((const char*)(gbase) + (voff)[_i]), (PG8_LAS unsigned*)(lds + (bufoff) + ldsw + _i * 8192), 16, 0, 0); } while (0)
#define PG8_LDA(dst, b, h) do { _Pragma("unroll") for (int m = 0; m < 4; ++m) _Pragma("unroll") for (int k = 0; k < 2; ++k) dst[m][k] = *(const PG8_LAS bf16x8*)(lds + PG8_SA(b, h) + aoff + m * 2048 + k * 1024); } while (0)
#define PG8_LDB(dst, b, h) do { _Pragma("unroll") for (int n = 0; n < 2; ++n) _Pragma("unroll") for (int k = 0; k < 2; ++k) dst[n][k] = *(const PG8_LAS bf16x8*)(lds + PG8_SB(b, h) + boff + n * 2048 + k * 1024); } while (0)
#define PG8_MMA(ai, bj, At, Bt) do { __builtin_amdgcn_s_setprio(1); _Pragma("unroll") for (int m = 0; m < 4; ++m) _Pragma("unroll") for (int n = 0; n < 2; ++n) _Pragma("unroll") for (int k = 0; k < 2; ++k) \
        acc[ai][bj][m][n] = __builtin_amdgcn_mfma_f32_16x16x32_bf16(Bt[n][k], At[m][k], acc[ai][bj][m][n], 0, 0, 0); __builtin_amdgcn_s_setprio(0); } while (0)
#define PG8_WAIT_V(n) asm volatile("s_waitcnt vmcnt(" #n ")" ::: "memory")
#define PG8_WAIT_L(n) asm volatile("s_waitcnt lgkmcnt(" #n ")" ::: "memory")
#define PG8_BAR __builtin_amdgcn_s_barrier()
#define PG8_SCHED __builtin_amdgcn_sched_barrier(0)
    Unit cur, nxt; int ui = 0;
    if (!S.next(0, cur)) return;
    f32x4 acc[2][2][4][2];
#pragma unroll
    for (int a = 0; a < 2; ++a)
#pragma unroll
        for (int b = 0; b < 2; ++b)
#pragma unroll
            for (int m = 0; m < 4; ++m)
#pragma unroll
                for (int n = 0; n < 2; ++n) acc[a][b][m][n] = (f32x4){0.f, 0.f, 0.f, 0.f};
    bf16x8 At[4][2], B0[2][2], B1[2][2];
    const char* cA = (const char*)g.A + (size_t)cur.pm * tstep; const char* cB = (const char*)g.Bt + (size_t)cur.pn * tstep;
    S.a_ready(cur);
    if constexpr (SP2) {
        PG8_STAGE(PG8_SB(0, 0), cB, voffB); PG8_STAGE(PG8_SB(0, 1), cB + hstep, voffB); PG8_STAGE(PG8_SA(0, 0), cA, voffA); PG8_STAGE(PG8_SA(0, 1), cA + hstep, voffA);
        if (wr == 1) PG8_BAR;
        PG8_WAIT_V(2); PG8_BAR;
        PG8_STAGE(PG8_SB(1, 0), cB + kstep, voffB); PG8_STAGE(PG8_SA(1, 0), cA + kstep, voffA); PG8_STAGE(PG8_SB(1, 1), cB + hstep + kstep, voffB);
        PG8_WAIT_V(6); PG8_BAR;
    } else {
        PG8_STAGE(PG8_SB(0, 0), cB, voffB); PG8_STAGE(PG8_SA(0, 0), cA, voffA); PG8_STAGE(PG8_SB(0, 1), cB + hstep, voffB); PG8_STAGE(PG8_SA(0, 1), cA + hstep, voffA);
        if (wr == 1) PG8_BAR;
        PG8_WAIT_V(4); PG8_BAR;
        PG8_STAGE(PG8_SB(1, 0), cB + kstep, voffB); PG8_STAGE(PG8_SA(1, 0), cA + kstep, voffA); PG8_STAGE(PG8_SB(1, 1), cB + hstep + kstep, voffB);
        PG8_WAIT_V(6); PG8_BAR;
    }
    for (;;) {
        const bool has_next = S.next(ui + 1, nxt);
        const char* nA = has_next ? (const char*)g.A + (size_t)nxt.pm * tstep : cA; const char* nB = has_next ? (const char*)g.Bt + (size_t)nxt.pn * tstep : cB;
        for (int t = 0; t < nt; t += 2) {
            const bool last = (t == nt - 2);
            const char* a1 = cA + (size_t)(t + 1) * kstep;
            const char* a2 = last ? nA : cA + (size_t)(t + 2) * kstep; const char* b2 = last ? nB : cB + (size_t)(t + 2) * kstep;
            const char* a3 = a2 + kstep; const char* b3 = b2 + kstep;
            if (last && has_next) S.a_ready(nxt);
            if constexpr (SP2) {
            PG8_LDB(B0, 0, 0); PG8_LDB(B1, 0, 1); PG8_SCHED; PG8_LDA(At, 0, 0); PG8_STAGE(PG8_SA(1, 1), a1 + hstep, voffA);
            PG8_WAIT_V(8); PG8_WAIT_L(0); PG8_BAR; PG8_MMA(0, 0, At, B0); PG8_MMA(0, 1, At, B1); PG8_BAR; PG8_SCHED;
            PG8_LDA(At, 0, 1); PG8_STAGE(PG8_SB(0, 0), b2, voffB); PG8_STAGE(PG8_SB(0, 1), b2 + hstep, voffB); PG8_STAGE(PG8_SA(0, 0), a2, voffA);
            PG8_WAIT_V(8); PG8_WAIT_L(0); PG8_BAR; PG8_MMA(1, 0, At, B0); PG8_MMA(1, 1, At, B1); PG8_BAR; PG8_SCHED;
            PG8_LDB(B0, 1, 0); PG8_LDB(B1, 1, 1); PG8_SCHED; PG8_LDA(At, 1, 0); PG8_STAGE(PG8_SA(0, 1), a2 + hstep, voffA);
            PG8_WAIT_V(8); PG8_WAIT_L(0); PG8_BAR; PG8_MMA(0, 0, At, B0); PG8_MMA(0, 1, At, B1); PG8_BAR; PG8_SCHED;
            PG8_LDA(At, 1, 1); PG8_STAGE(PG8_SB(1, 0), b3, voffB); PG8_STAGE(PG8_SB(1, 1), b3 + hstep, voffB); PG8_STAGE(PG8_SA(1, 0), a3, voffA);
            PG8_WAIT_V(8); PG8_WAIT_L(0); PG8_BAR; PG8_MMA(1, 0, At, B0); PG8_MMA(1, 1, At, B1); PG8_BAR; PG8_SCHED;
            } else {
            PG8_LDB(B0, 0, 0); PG8_SCHED; PG8_LDA(At, 0, 0); PG8_STAGE(PG8_SA(1, 1), a1 + hstep, voffA);
            PG8_WAIT_L(8); PG8_BAR; PG8_WAIT_L(0); PG8_MMA(0, 0, At, B0); PG8_BAR; PG8_SCHED;
            PG8_LDB(B1, 0, 1); PG8_STAGE(PG8_SB(0, 0), b2, voffB);
            PG8_BAR; PG8_WAIT_L(0); PG8_MMA(0, 1, At, B1); PG8_BAR;
            PG8_LDA(At, 0, 1); PG8_STAGE(PG8_SA(0, 0), a2, voffA);
            PG8_BAR; PG8_WAIT_L(0); PG8_MMA(1, 0, At, B0); PG8_BAR; PG8_SCHED;
            PG8_STAGE(PG8_SB(0, 1), b2 + hstep, voffB);
            PG8_WAIT_V(6); PG8_BAR; PG8_MMA(1, 1, At, B1); PG8_BAR;
            PG8_LDB(B0, 1, 0); PG8_SCHED; PG8_LDA(At, 1, 0); PG8_STAGE(PG8_SA(0, 1), a2 + hstep, voffA);
            PG8_WAIT_L(8); PG8_BAR; PG8_WAIT_L(0); PG8_MMA(0, 0, At, B0); PG8_BAR; PG8_SCHED;
            PG8_LDB(B1, 1, 1); PG8_STAGE(PG8_SB(1, 0), b3, voffB);
            PG8_BAR; PG8_WAIT_L(0); PG8_MMA(0, 1, At, B1); PG8_BAR;
            PG8_LDA(At, 1, 1); PG8_STAGE(PG8_SA(1, 0), a3, voffA);
            PG8_BAR; PG8_WAIT_L(0); PG8_MMA(1, 0, At, B0); PG8_BAR; PG8_SCHED;
            PG8_STAGE(PG8_SB(1, 1), b3 + hstep, voffB);
            PG8_WAIT_V(6); PG8_BAR; PG8_MMA(1, 1, At, B1); PG8_BAR;
            }
        }
        if constexpr (ALIGN_EPI) { if (wr == 0) PG8_BAR; }
        if constexpr (!Epi::AFTER_DRAIN) { E(acc, cur, ui, wr, wc, fr, fq); S.done(cur); }
        if (!has_next) break;
#pragma unroll
        for (int a = 0; a < 2; ++a)
#pragma unroll
            for (int b = 0; b < 2; ++b)
#pragma unroll
                for (int m = 0; m < 4; ++m)
#pragma unroll
                    for (int n = 0; n < 2; ++n) acc[a][b][m][n] = (f32x4){0.f, 0.f, 0.f, 0.f};
        cur = nxt; cA = nA; cB = nB; ++ui;
        if constexpr (ALIGN_EPI) { if (wr == 1) PG8_BAR; }
    }
    PG8_WAIT_V(0);
    if constexpr (!ALIGN_EPI) { if (wr == 0) PG8_BAR; }
    PG8_BAR;
    if constexpr (Epi::AFTER_DRAIN) { E.fused(acc, cur, wr, wc, fr, fq, lds, wid, lane); S.done(cur); }
#undef PG8_SA
#undef PG8_SB
#undef PG8_STAGE
#undef PG8_LDA
#undef PG8_LDB
#undef PG8_MMA
#undef PG8_WAIT_V
#undef PG8_WAIT_L
#undef PG8_BAR
#undef PG8_SCHED
}
}

namespace cg = cooperative_groups;
#define LAS __attribute__((address_space(3)))
typedef unsigned short bf16;
typedef unsigned v4u __attribute__((ext_vector_type(4)));
typedef unsigned v2u __attribute__((ext_vector_type(2)));
typedef float f32x4 __attribute__((ext_vector_type(4)));
typedef float f32x2 __attribute__((ext_vector_type(2)));
typedef short bf16x8 __attribute__((ext_vector_type(8)));

constexpr int NTHR = 512, NWAVES = 8;
constexpr int M = 32768, D = 1024, FF = 2816, SEQ = 8192;
constexpr int N_UP = 2 * FF, N_AB = 1536, N_SGU = 2048;
constexpr float EPS = 1e-6f;
constexpr int LDS_BYTES = 147456;
constexpr int N_PHASES = 16;

constexpr size_t MiB = 1u << 20;
constexpr size_t WS_H = 0;
constexpr size_t WS_A2 = WS_H + 64 * MiB, WS_A3 = WS_H + 128 * MiB;
constexpr size_t WS_WUP = 192 * MiB, SZ_WUP = (size_t)N_UP * D * 2;
constexpr size_t WS_WDN = WS_WUP + 4 * SZ_WUP, SZ_WDN = (size_t)D * FF * 2;
constexpr size_t WS_WABI = WS_WDN + 4 * SZ_WDN;
constexpr size_t WS_WABO = WS_WABI + (size_t)N_AB * D * 2;
constexpr size_t WS_WSGI = WS_WABO + (size_t)D * D * 2;
constexpr size_t WS_WSGO = WS_WSGI + (size_t)N_SGU * D * 2;
constexpr size_t WS_WM = WS_WSGO + (size_t)D * D * 2;
constexpr size_t WS_SSP = WS_WM + 1 * MiB;
constexpr size_t WS_VST = WS_SSP + (size_t)M * 16 * 4;
constexpr size_t WS_BIAS2 = WS_VST + (size_t)M * 16 * 8;
constexpr size_t WS_CTL = WS_BIAS2 + 1 * MiB, CTL_BYTES = 16384;
constexpr size_t WS_XB = WS_CTL + 1 * MiB;
constexpr size_t WS_END = WS_XB + 64 * MiB;

__device__ __forceinline__ unsigned f2bf(float f) { unsigned u = __builtin_bit_cast(unsigned, f); return (u + 0x7fffu + ((u >> 16) & 1u)) >> 16; }
__device__ __forceinline__ unsigned pk2(float lo, float hi) { return pg8::cvt_pk_bf16(lo, hi); }
__device__ __forceinline__ float bf2f(unsigned short h) { return __builtin_bit_cast(float, (unsigned)h << 16); }
#define LDS_WAIT() asm volatile("s_waitcnt lgkmcnt(0)" ::: "memory")

struct Args { const float* in[24]; float* out; unsigned char* ws; size_t ws_off; int ph_lo, ph_hi; };
typedef __attribute__((address_space(4))) const Args CArgs;

__device__ __forceinline__ void tr_item(const float* W, int N, bf16* WT, int ldt, int drow0, const float* gain, LAS float* scr, int k0, int n0, int lane) {
    float v[32];
#pragma unroll
    for (int i = 0; i < 32; ++i) { const int kk = 2 * i + (lane >> 5); v[i] = __builtin_nontemporal_load(&W[(size_t)(k0 + kk) * N + n0 + (lane & 31)]); }
#pragma unroll
    for (int i = 0; i < 32; ++i) { const int kk = 2 * i + (lane >> 5); scr[kk * 33 + (lane & 31)] = v[i]; }
    LDS_WAIT(); asm volatile("" ::: "memory");
    const int c = lane & 7;
    f32x4 g0 = (f32x4){1.f, 1.f, 1.f, 1.f}, g1 = g0;
    if (gain) { g0 = *(const f32x4*)(gain + k0 + 8 * c); g1 = *(const f32x4*)(gain + k0 + 8 * c + 4); }
#pragma unroll
    for (int j = 0; j < 4; ++j) { const int n = (lane >> 3) + 8 * j; const LAS float* s = scr + (8 * c) * 33 + n;
        v4u o; o.x = pk2(s[0 * 33] * g0[0], s[1 * 33] * g0[1]); o.y = pk2(s[2 * 33] * g0[2], s[3 * 33] * g0[3]); o.z = pk2(s[4 * 33] * g1[0], s[5 * 33] * g1[1]); o.w = pk2(s[6 * 33] * g1[2], s[7 * 33] * g1[3]);
        *(v4u*)(WT + (size_t)(drow0 + n) * ldt + k0 + 8 * c) = o; }
    LDS_WAIT(); asm volatile("" ::: "memory");
}
__device__ __forceinline__ int ilv_row(int n, int half) { const int hi = n >= half ? 1 : 0, nn = n - hi * half; return 256 * (nn >> 7) + 128 * hi + (nn & 127); }

__device__ __forceinline__ void prologue(CArgs* a, LAS unsigned char* lds, int gw, int NGW, int wave, int lane) {
    asm volatile("" : "+v"(lane));
    unsigned char* ws = a->ws + a->ws_off;
    LAS float* scr = (LAS float*)(lds + wave * 16384);
    constexpr int I_UP = (D / 64) * (N_UP / 32), I_DN = (FF / 64) * (D / 32), I_ABI = (D / 64) * (N_AB / 32), I_ABO = (512 / 64) * (D / 32), I_SGI = (D / 64) * (N_SGU / 32), I_SGO = (D / 64) * (D / 32);
    constexpr int NITEMS = 4 * I_UP + 4 * I_DN + I_ABI + I_ABO + I_SGI + I_SGO;
    for (int it = gw; it < NITEMS; it += NGW) {
        int r = it;
        if (r < 4 * I_UP) { const int s = r / I_UP, q = r % I_UP, l = s >> 1, f = s & 1; const int nblk = N_UP / 32, k0 = 64 * (q / nblk), n0 = 32 * (q % nblk);
            const float* W = (f ? a->in[6] : a->in[2]) + (size_t)l * D * N_UP; const float* g = (f ? a->in[5] : a->in[1]) + l * D;
            tr_item(W, N_UP, (bf16*)(ws + WS_WUP + s * SZ_WUP), D, ilv_row(n0, FF), g, scr, k0, n0, lane); continue; }
        r -= 4 * I_UP;
        if (r < 4 * I_DN) { const int s = r / I_DN, q = r % I_DN, l = s >> 1, f = s & 1; const int nblk = D / 32, k0 = 64 * (q / nblk), n0 = 32 * (q % nblk);
            const float* W = (f ? a->in[7] : a->in[3]) + (size_t)l * FF * D;
            tr_item(W, D, (bf16*)(ws + WS_WDN + s * SZ_WDN), FF, n0, nullptr, scr, k0, n0, lane); continue; }
        r -= 4 * I_DN;
        if (r < I_ABI) { const int nblk = N_AB / 32, k0 = 64 * (r / nblk), n0 = 32 * (r % nblk);
            const int drow = n0 < 512 ? n0 : 512 + ilv_row(n0 - 512, 512);
            tr_item(a->in[8], N_AB, (bf16*)(ws + WS_WABI), D, drow, a->in[4], scr, k0, n0, lane); continue; }
        r -= I_ABI;
        if (r < I_ABO) { const int nblk = D / 32, k0 = 512 + 64 * (r / nblk), n0 = 32 * (r % nblk);
            tr_item(a->in[16], D, (bf16*)(ws + WS_WABO), D, n0, nullptr, scr, k0, n0, lane); continue; }
        r -= I_ABO;
        if (r < I_SGI) { const int nblk = N_SGU / 32, k0 = 64 * (r / nblk), n0 = 32 * (r % nblk);
            tr_item(a->in[17], N_SGU, (bf16*)(ws + WS_WSGI), D, n0, a->in[4] + D, scr, k0, n0, lane); continue; }
        r -= I_SGI;
        { const int nblk = D / 32, k0 = 64 * (r / nblk), n0 = 32 * (r % nblk);
            tr_item(a->in[22], D, (bf16*)(ws + WS_WSGO), D, n0, nullptr, scr, k0, n0, lane); }
    }
    {   const float* pw = a->in[9]; const float* psc = a->in[11]; const float* wo = a->in[16]; bf16* WT = (bf16*)(ws + WS_WABO);
        for (int it = gw; it < 128 * 16; it += NGW) { const int k4 = it >> 4, nb = it & 15, g = k4 >> 5, kc0 = (k4 & 31) * 4, n = nb * 64 + lane;
            float acc[4] = {0.f, 0.f, 0.f, 0.f};
#pragma unroll 16
            for (int d = 0; d < 128; ++d) { const float wv = wo[(size_t)(g * 128 + d) * D + n] * psc[g * 128 + d];
#pragma unroll
                for (int i = 0; i < 4; ++i) acc[i] += pw[(size_t)((g * 128) + kc0 + i) * 128 + d] * wv; }
            v2u o; o.x = pk2(acc[0], acc[1]); o.y = pk2(acc[2], acc[3]);
            *(v2u*)(WT + (size_t)n * D + k4 * 4) = o; }
        const float* pb = a->in[10]; float* b2 = (float*)(ws + WS_BIAS2);
        for (int n = gw; n < D; n += NGW) { float s = 0.f;
#pragma unroll
            for (int j = 0; j < 8; ++j) { const int k = lane + 64 * j; s += pb[k] * psc[k] * wo[(size_t)k * D + n]; }
#pragma unroll
            for (int o = 1; o < 64; o <<= 1) s += __shfl_xor(s, o);
            if (lane == 0) b2[n] = s; }
    }
    {   const float* sw = a->in[20]; bf16* WM = (bf16*)(ws + WS_WM);
        for (int i = gw * 64 + lane; i < 8 * 128 * 128; i += NGW * 64) { const int s = (i >> 7) & 127, t = i & 127; WM[i] = (bf16)f2bf(t <= s ? sw[i] : 0.f); } }
    {   const float* x = a->in[0]; bf16* XB = (bf16*)(ws + WS_XB); float* ssp = (float*)(ws + WS_SSP);
        for (int mb = gw; mb < M; mb += 2 * NGW) { f32x4 v[2][4]; float s[2] = {0.f, 0.f};
#pragma unroll
            for (int rr = 0; rr < 2; ++rr) { const int m = mb + rr * NGW; if (m < M) { const f32x4* xr = (const f32x4*)(x + (size_t)m * D) + lane;
#pragma unroll
                for (int j = 0; j < 4; ++j) v[rr][j] = __builtin_nontemporal_load(&xr[64 * j]); } }
#pragma unroll
            for (int rr = 0; rr < 2; ++rr) { const int m = mb + rr * NGW; if (m < M) {
#pragma unroll
                for (int j = 0; j < 4; ++j) s[rr] += (v[rr][j][0] * v[rr][j][0] + v[rr][j][1] * v[rr][j][1]) + (v[rr][j][2] * v[rr][j][2] + v[rr][j][3] * v[rr][j][3]);
#pragma unroll
                for (int o = 1; o < 64; o <<= 1) s[rr] += __shfl_xor(s[rr], o);
                v2u* o8 = (v2u*)(XB + (size_t)m * D) + lane;
#pragma unroll
                for (int j = 0; j < 4; ++j) { v2u w; w.x = pk2(v[rr][j][0], v[rr][j][1]); w.y = pk2(v[rr][j][2], v[rr][j][3]); o8[64 * j] = w; }
                if (lane < 16) ssp[(size_t)m * 16 + lane] = lane == 0 ? s[rr] : 0.f; } } } }
}

__device__ __forceinline__ f32x2 bf2x2(unsigned w) { return (f32x2){__builtin_bit_cast(float, w << 16), __builtin_bit_cast(float, w & 0xffff0000u)}; }
__device__ __forceinline__ void pc_pass(int Q, const bf16* UG, bf16* A2, const float* cw, const float* cbias, LAS float* Yw, int mt, int ts, int lane) {
    asm volatile("" : "+v"(lane));
    const int c0 = 128 * Q + 2 * lane;
    f32x2 w[31]; unsigned graw[38], uraw[23];
#pragma unroll
    for (int i = 0; i < 38; ++i) { const int t = ts - 30 + i; graw[i] = (t >= 0) ? *(const unsigned*)(UG + (size_t)(mt - 30 + i) * 1024 + 512 + c0) : 0u; }
#pragma unroll
    for (int i = 0; i < 23; ++i) { const int t = ts - 15 + i; uraw[i] = (t >= 0) ? *(const unsigned*)(UG + (size_t)(mt - 15 + i) * 1024 + c0) : 0u; }
#pragma unroll
    for (int j = 0; j < 31; ++j) w[j] = *(const f32x2*)(cw + j * 512 + c0);
    const f32x2 cb = *(const f32x2*)(cbias + c0);
#define PC_POOL(WIN) do { _Pragma("unroll") for (int t = 0; t < 8; ++t) { const f32x2 ut = bf2x2(uraw[15 + t]); f32x2 s = ut; _Pragma("unroll") for (int j = 1; j < WIN; ++j) s += bf2x2(uraw[15 + t - j]); \
        const int cnt = min(ts + t + 1, WIN); const f32x2 p = s * __builtin_amdgcn_rcpf((float)cnt) - ut; *(unsigned*)(A2 + (size_t)(mt + t) * 1024 + c0) = pk2(p.x, p.y); } } while (0)
    if (Q == 0) PC_POOL(2); else if (Q == 1) PC_POOL(4); else if (Q == 2) PC_POOL(8); else PC_POOL(16);
#undef PC_POOL
    f32x2 y[8];
#pragma unroll
    for (int t = 0; t < 8; ++t) y[t] = cb;
#pragma unroll
    for (int i = 0; i < 38; ++i) { const f32x2 gv = bf2x2(graw[i]);
#pragma unroll
        for (int t = 0; t < 8; ++t) if (i - t >= 0 && i - t < 31) y[t] = __builtin_elementwise_fma(w[i - t], gv, y[t]); }
#pragma unroll
    for (int t = 0; t < 8; ++t) *(LAS f32x2*)(Yw + t * 512 + c0) = y[t];
}
__device__ __forceinline__ void poolconv_phase(CArgs* a, LAS unsigned char* lds, int G, int tid, int wave, int lane) {
    asm volatile("" : "+v"(tid), "+v"(lane));
    const bf16* UG = (const bf16*)(a->ws + a->ws_off + WS_H); bf16* A2 = (bf16*)(a->ws + a->ws_off + WS_A2);
    const float* cw = a->in[12]; const float* cbias = a->in[13];
    LAS float* Yw = (LAS float*)(lds + wave * 16384);
    const int c8 = 8 * lane;
    const f32x4 lg0 = *(const f32x4*)(a->in[14] + c8), lg1 = *(const f32x4*)(a->in[14] + c8 + 4), lb0 = *(const f32x4*)(a->in[15] + c8), lb1 = *(const f32x4*)(a->in[15] + c8 + 4);
    for (int unit = blockIdx.x; unit < M / 64; unit += G) {
        const int mt = unit * 64 + 8 * wave, ts = mt & (SEQ - 1);
#define PC_FENCE() do { asm volatile("" ::: "memory"); __builtin_amdgcn_sched_barrier(0); } while (0)
        _Pragma("unroll 1") for (int q = 0; q < 4; ++q) { pc_pass(q, UG, A2, cw, cbias, Yw, mt, ts, lane); PC_FENCE(); }
#undef PC_FENCE
#pragma unroll 2
        for (int t = 0; t < 8; ++t) { const LAS f32x4* yr = (const LAS f32x4*)(Yw + t * 512 + c8); const f32x4 p0 = yr[0], p1 = yr[1];
            float s1 = (p0[0] + p0[1]) + (p0[2] + p0[3]) + (p1[0] + p1[1]) + (p1[2] + p1[3]);
            float s2 = (p0[0] * p0[0] + p0[1] * p0[1]) + (p0[2] * p0[2] + p0[3] * p0[3]) + (p1[0] * p1[0] + p1[1] * p1[1]) + (p1[2] * p1[2] + p1[3] * p1[3]);
#pragma unroll
            for (int o = 1; o < 64; o <<= 1) { s1 += __shfl_xor(s1, o); s2 += __shfl_xor(s2, o); }
            const float mean = s1 * (1.f / 512.f), rs = __builtin_amdgcn_rsqf(s2 * (1.f / 512.f) - mean * mean + EPS);
            const f32x4 v0 = (p0 - mean) * rs * lg0 + lb0, v1 = (p1 - mean) * rs * lg1 + lb1;
            v4u o; o.x = pk2(pg8::silu_f(v0[0]), pg8::silu_f(v0[1])); o.y = pk2(pg8::silu_f(v0[2]), pg8::silu_f(v0[3])); o.z = pk2(pg8::silu_f(v1[0]), pg8::silu_f(v1[1])); o.w = pk2(pg8::silu_f(v1[2]), pg8::silu_f(v1[3]));
            *(v4u*)(A2 + (size_t)(mt + t) * 1024 + 512 + c8) = o; }
    }
}

typedef short s16x4 __attribute__((ext_vector_type(4)));
__device__ __forceinline__ void sgu_phase(CArgs* a, LAS unsigned char* lds, int G, int tid, int wave, int lane) {
    asm volatile("" : "+v"(tid), "+v"(lane));
    const bf16* Z = (const bf16*)(a->ws + a->ws_off + WS_H); bf16* A3 = (bf16*)(a->ws + a->ws_off + WS_A3); const f32x2* vst = (const f32x2*)(a->ws + a->ws_off + WS_VST); const bf16* WM = (const bf16*)(a->ws + a->ws_off + WS_WM);
    const float* lng = a->in[18]; const float* lnb = a->in[19]; const float* sb = a->in[21];
    constexpr int VS = 272;
    LAS unsigned char* VN = lds;
    LAS float* ST = (LAS float*)(lds + 36864);
    const int fr = lane & 15, fq = lane >> 4;
    const int c8 = (tid & 15) << 3, t0 = tid >> 4;
    const int troff = (8 * fq + (fr >> 2)) * VS + 8 * (lane & 3);
    const int nkk = (wave >> 1) + 1;
    for (int chunk = blockIdx.x; chunk < M / 128; chunk += G) {
        const int m0 = chunk * 128;
        if (tid < 128) { const f32x2* p = vst + (size_t)(m0 + tid) * 16; float s1 = 0.f, s2 = 0.f;
#pragma unroll
            for (int i = 0; i < 16; ++i) { const f32x2 q = p[i]; s1 += q.x; s2 += q.y; }
            const float mean = s1 * (1.f / 1024.f), var = s2 * (1.f / 1024.f) - mean * mean;
            ST[2 * tid] = mean; ST[2 * tid + 1] = __builtin_amdgcn_rsqf(var + EPS); }
        v4u x[4];
#pragma unroll
        for (int i = 0; i < 4; ++i) x[i] = *(const v4u*)(Z + (size_t)(m0 + t0 + 32 * i) * 2048 + 1024 + c8);
        __syncthreads();
#pragma unroll 1
        for (int h = 0; h < 8; ++h) {
            {   const f32x4 g0 = *(const f32x4*)(lng + h * 128 + c8), g1 = *(const f32x4*)(lng + h * 128 + c8 + 4), b0 = *(const f32x4*)(lnb + h * 128 + c8), b1 = *(const f32x4*)(lnb + h * 128 + c8 + 4);
#pragma unroll
                for (int i = 0; i < 4; ++i) { const int t = t0 + 32 * i; const float mu = ST[2 * t], rs = ST[2 * t + 1];
                    const unsigned xs[4] = {x[i].x, x[i].y, x[i].z, x[i].w}; float lo[4], hi[4];
#pragma unroll
                    for (int e = 0; e < 4; ++e) { lo[e] = (__builtin_bit_cast(float, xs[e] << 16) - mu) * rs; hi[e] = (__builtin_bit_cast(float, xs[e] & 0xffff0000u) - mu) * rs; }
                    v4u o; o.x = pk2(lo[0] * g0[0] + b0[0], hi[0] * g0[1] + b0[1]); o.y = pk2(lo[1] * g0[2] + b0[2], hi[1] * g0[3] + b0[3]);
                    o.z = pk2(lo[2] * g1[0] + b1[0], hi[2] * g1[1] + b1[1]); o.w = pk2(lo[3] * g1[2] + b1[2], hi[3] * g1[3] + b1[3]);
                    *(LAS v4u*)(VN + t * VS + c8 * 2) = o; } }
            const int s = wave * 16 + fr; const size_t row = (size_t)(m0 + s);
            bf16x8 xfr[4];
#pragma unroll
            for (int kk = 0; kk < 4; ++kk) if (kk < nkk) xfr[kk] = *(const bf16x8*)(WM + (size_t)(h * 128 + s) * 128 + 32 * kk + 8 * fq);
            const float bs = sb[h * 128 + s];
            v2u uu[8];
#pragma unroll
            for (int cbk = 0; cbk < 8; ++cbk) uu[cbk] = *(const v2u*)(Z + row * 2048 + h * 128 + 16 * cbk + 4 * fq);
            __syncthreads();
            if (h < 7) {
#pragma unroll
                for (int i = 0; i < 4; ++i) x[i] = *(const v4u*)(Z + (size_t)(m0 + t0 + 32 * i) * 2048 + 1024 + (h + 1) * 128 + c8); }
            f32x4 acc[8];
#pragma unroll
            for (int cbk = 0; cbk < 8; ++cbk) acc[cbk] = (f32x4){0.f, 0.f, 0.f, 0.f};
#pragma unroll
            for (int kk = 0; kk < 4; ++kk) if (kk < nkk) { const bf16x8 xf = xfr[kk];
#pragma unroll
                for (int cbk = 0; cbk < 8; ++cbk) {
                    const s16x4 p0 = __builtin_amdgcn_ds_read_tr16_b64_v4i16((LAS s16x4*)(VN + troff + (32 * kk) * VS + 32 * cbk));
                    const s16x4 p1 = __builtin_amdgcn_ds_read_tr16_b64_v4i16((LAS s16x4*)(VN + troff + (32 * kk + 4) * VS + 32 * cbk));
                    const bf16x8 yf = __builtin_shufflevector(p0, p1, 0, 1, 2, 3, 4, 5, 6, 7);
                    acc[cbk] = __builtin_amdgcn_mfma_f32_16x16x32_bf16(yf, xf, acc[cbk], 0, 0, 0); } }
#pragma unroll
            for (int cbk = 0; cbk < 8; ++cbk) { const int col = h * 128 + 16 * cbk + 4 * fq;
                const float u0 = __builtin_bit_cast(float, uu[cbk].x << 16), u1 = __builtin_bit_cast(float, uu[cbk].x & 0xffff0000u), u2 = __builtin_bit_cast(float, uu[cbk].y << 16), u3 = __builtin_bit_cast(float, uu[cbk].y & 0xffff0000u);
                v2u o; o.x = pk2(u0 * (acc[cbk][0] + bs), u1 * (acc[cbk][1] + bs)); o.y = pk2(u2 * (acc[cbk][2] + bs), u3 * (acc[cbk][3] + bs));
                *(v2u*)(A3 + row * 1024 + col) = o; }
            __syncthreads();
        }
    }
}

__device__ __forceinline__ void final_phase(CArgs* a, int gw, int NGW, int lane) {
    asm volatile("" : "+v"(lane));
    float* X = a->out; const bf16* XB = (const bf16*)(a->ws + a->ws_off + WS_XB); const float* ssp = (const float*)(a->ws + a->ws_off + WS_SSP); const float* g = a->in[23];
    for (int mb = gw; mb < M; mb += 2 * NGW) { v4u raw[2][2]; float sp[2];
#pragma unroll
        for (int rr = 0; rr < 2; ++rr) { const int m = mb + rr * NGW; if (m < M) { sp[rr] = ssp[(size_t)m * 16 + (lane & 15)];
#pragma unroll
            for (int j = 0; j < 2; ++j) raw[rr][j] = *((const v4u*)(XB + (size_t)m * D) + lane + 64 * j); } }
#pragma unroll
        for (int rr = 0; rr < 2; ++rr) { const int m = mb + rr * NGW; if (m < M) { float s = sp[rr];
            s += __shfl_xor(s, 1); s += __shfl_xor(s, 2); s += __shfl_xor(s, 4); s += __shfl_xor(s, 8);
            const float r = __builtin_amdgcn_rsqf(s * (1.f / 1024.f) + EPS);
#pragma unroll
            for (int j = 0; j < 2; ++j) { const v4u w = raw[rr][j]; const int col = 8 * (lane + 64 * j);
                const f32x4 g0 = *(const f32x4*)(g + col), g1 = *(const f32x4*)(g + col + 4);
                const f32x4 v0 = (f32x4){__builtin_bit_cast(float, w.x << 16), __builtin_bit_cast(float, w.x & 0xffff0000u), __builtin_bit_cast(float, w.y << 16), __builtin_bit_cast(float, w.y & 0xffff0000u)};
                const f32x4 v1 = (f32x4){__builtin_bit_cast(float, w.z << 16), __builtin_bit_cast(float, w.z & 0xffff0000u), __builtin_bit_cast(float, w.w << 16), __builtin_bit_cast(float, w.w & 0xffff0000u)};
                __builtin_nontemporal_store(v0 * r * g0, (f32x4*)(X + (size_t)m * D + col)); __builtin_nontemporal_store(v1 * r * g1, (f32x4*)(X + (size_t)m * D + col + 4)); } } } }
}

#define RLX_AGENT __ATOMIC_RELAXED, __HIP_MEMORY_SCOPE_AGENT
#define XB_TMO      128
#define XB_XCNT(j)  (256  + 64 * (j))
#define XB_XSUB(j)  (1280 + 64 * (j))
#define XB_XGEN(j)  (2304 + 64 * (j))
#define XB_TOP      3328
#define XB_TOPGEN   3392
#define XCD_BAR_WORDS 3456
#define XB_SPIN_CAP (1u << 18)

__device__ __forceinline__ unsigned xb_ld(unsigned* p)              { return __hip_atomic_load(p, __ATOMIC_RELAXED, __HIP_MEMORY_SCOPE_AGENT); }
__device__ __forceinline__ unsigned xb_add(unsigned* p, unsigned v) { return __hip_atomic_fetch_add(p, v, __ATOMIC_RELAXED, __HIP_MEMORY_SCOPE_AGENT); }
__device__ __forceinline__ unsigned xb_xcc_id() { return (unsigned)__builtin_amdgcn_s_getreg((3 << 11) | 20) & 0xFu; }
#define XB_SPIN(cond, bar) do { unsigned _sp = 0; while (cond) { __builtin_amdgcn_s_sleep(1); \
    if ((++_sp & 255u) == 0u) { if (xb_ld(&(bar)[XB_TMO])) break; if (_sp > XB_SPIN_CAP) { atomicAdd(&(bar)[XB_TMO], 1u); break; } } } } while (0)

struct XcdBarrier {
    unsigned* bar; unsigned x;
    volatile LAS unsigned* st;
};

__device__ __forceinline__ XcdBarrier xcd_barrier_post(unsigned* bar, volatile LAS unsigned* st) {
    XcdBarrier b; b.bar = bar; b.x = xb_xcc_id(); b.st = st;
    if (threadIdx.x == 0) (void)xb_add(&bar[XB_XCNT(b.x)], 1u);
    return b;
}
__device__ __forceinline__ void xcd_barrier_complete(unsigned* bar, unsigned x, unsigned& nloc, unsigned& nx) {
    const unsigned G = gridDim.x * gridDim.y * gridDim.z;
    unsigned sum, cnt, mine, sp = 0u;
    for (;;) {
        sum = 0u; cnt = 0u; mine = 0u;
#pragma unroll
        for (unsigned j = 0; j < 16; ++j) { const unsigned c = xb_ld(&bar[XB_XCNT(j)]); sum += c; cnt += (c > 0u) ? 1u : 0u; mine = (j == x) ? c : mine; }
        if (sum == G) break;
        __builtin_amdgcn_s_sleep(1);
        if ((++sp & 255u) == 0u) { if (xb_ld(&bar[XB_TMO])) break; if (sp > XB_SPIN_CAP) { atomicAdd(&bar[XB_TMO], 1u); break; } }
    }
    nloc = mine > 0u ? mine : 1u; nx = cnt > 0u ? cnt : 1u;
}

__device__ __forceinline__ void xcd_barrier(const XcdBarrier& b) {
    asm volatile("s_waitcnt vmcnt(0)" ::: "memory");
    __syncthreads();
    if (threadIdx.x == 0) {
        unsigned* bar = b.bar;
        __builtin_amdgcn_s_waitcnt(0);
        unsigned nloc = b.st[0], nx = b.st[1];
        if (nloc == 0u) { xcd_barrier_complete(bar, b.x, nloc, nx); b.st[0] = nloc; b.st[1] = nx; }
        const unsigned old = xb_add(&bar[XB_XSUB(b.x)], 1u);
        const unsigned gen = old / nloc;
        if (old + 1u == (gen + 1u) * nloc) {
            __builtin_amdgcn_fence(__ATOMIC_RELEASE, "agent");
            asm volatile("s_waitcnt vmcnt(0)" ::: "memory");
            const unsigned og = xb_add(&bar[XB_TOP], 1u);
            const unsigned tg = og / nx;
            if (og + 1u == (tg + 1u) * nx) xb_add(&bar[XB_TOPGEN], 1u);
            else XB_SPIN(xb_ld(&bar[XB_TOPGEN]) == tg, bar);
            __builtin_amdgcn_fence(__ATOMIC_ACQUIRE, "agent");
            xb_add(&bar[XB_XGEN(b.x)], 1u);
            asm volatile("s_waitcnt vmcnt(0)" ::: "memory");
        } else {
            XB_SPIN(xb_ld(&bar[XB_XGEN(b.x)]) == gen, bar);
            __builtin_amdgcn_fence(__ATOMIC_ACQUIRE, "agent");
            asm volatile("s_waitcnt vmcnt(0)" ::: "memory");
        }
    }
    __syncthreads();
}

__device__ __forceinline__ void build_rstd_table(LAS unsigned char* lds, const float* ssp, const pg8::StaticOrder& S, int tid) {
    asm volatile("" : "+v"(tid));
    f32x4 p[6][4]; bool ok[6];
#pragma unroll
    for (int k = 0; k < 6; ++k) { pg8::Unit u; ok[k] = S.next((tid >> 8) + 2 * k, u);
        if (ok[k]) { const f32x4* q = (const f32x4*)(ssp + (size_t)(u.pm * 256 + (tid & 255)) * 16);
#pragma unroll
            for (int j = 0; j < 4; ++j) p[k][j] = q[j]; } }
#pragma unroll
    for (int k = 0; k < 6; ++k) if (ok[k]) { float s = 0.f;
#pragma unroll
        for (int j = 0; j < 4; ++j) s += (p[k][j][0] + p[k][j][1]) + (p[k][j][2] + p[k][j][3]);
        *(LAS float*)(lds + pg8::RSTD_OFF + (((tid >> 8) + 2 * k) * 256 + (tid & 255)) * 4) = __builtin_amdgcn_rsqf(s * (1.0f / 1024.0f) + EPS); }
    __syncthreads();
}
#ifndef MK_PER_PHASE
#define MK_PER_PHASE 0
#endif
#ifndef PROBE_DUP
#define PROBE_DUP 0
#endif
__global__ void __launch_bounds__(NTHR) mk_fwd(Args args) {
    __shared__ __attribute__((aligned(16))) unsigned char lds_raw[LDS_BYTES];
    LAS unsigned char* lds = (LAS unsigned char*)lds_raw;
    cg::grid_group grid = cg::this_grid();
    const int tid = threadIdx.x, lane = tid & 63, wave = __builtin_amdgcn_readfirstlane(tid >> 6);
    const int G = gridDim.x, gw = blockIdx.x * NWAVES + wave, NGW = G * NWAVES;
    CArgs* ap = (CArgs*)__builtin_amdgcn_kernarg_segment_ptr();
#define ARGS() ({ CArgs* p_ = ap; asm volatile("" : "+s"(p_)); p_; })
#define WSP(off) (ARGS()->ws + (off))
#if MK_PER_PHASE
    const int lo = ap->ph_lo, hi = ap->ph_hi;
#else
    constexpr int lo = 0, hi = N_PHASES;
#endif
    int ph = 0;
#define MISCP ((volatile LAS unsigned*)(lds + 131072 + 320))
    if (tid < 32) MISCP[tid] = 0u;
    __syncthreads();
    if (hi - lo > 1) (void)xcd_barrier_post((unsigned*)(ap->ws + ap->ws_off + WS_CTL), MISCP + 8);
#define IN_PH() (lo <= ph && ph < hi)
#define SEAM() do { if (lo <= ph && ph + 1 < hi) { if (ap->ph_hi < 0) grid.sync();     { XcdBarrier b_; { CArgs* q_ = ARGS(); b_.bar = (unsigned*)(q_->ws + q_->ws_off + WS_CTL); } b_.x = xb_xcc_id(); b_.st = MISCP + 8; xcd_barrier(b_); } } ++ph; } while (0)

#pragma unroll 1
    for (int rep_ = 0; rep_ < ((PROBE_DUP & 1) ? 2 : 1); ++rep_)
    if (IN_PH()) prologue(ARGS(), lds, gw, NGW, wave, lane);
    SEAM();
#pragma unroll 1
    for (int s = 0; s < 4; ++s) {
#ifndef NO_PH_UP
#pragma unroll 1
        for (int rep_ = 0; rep_ < ((PROBE_DUP & (2 | 32)) ? 2 : 1); ++rep_)
        if (IN_PH()) { CArgs* A_ = ARGS(); unsigned char* ws = A_->ws + A_->ws_off; bf16* XB = (bf16*)(ws + WS_XB); bf16* H = (bf16*)(ws + WS_H); float* SSP = (float*)(ws + WS_SSP); (void)XB; (void)H; (void)SSP;
            pg8::Gemm g{XB, (const bf16*)(ws + WS_WUP + s * SZ_WUP), M, N_UP, D}; pg8::StaticOrder S; S.init(M, N_UP, G, (int)blockIdx.x);
            build_rstd_table(lds, SSP, S, tid);
            pg8::EpiSwiglu E{H, FF, lds, (PROBE_DUP & 32) ? rep_ : 0};
            pg8::gemm_phase<pg8::EpiSwiglu, pg8::StaticOrder, true, true>(lds, g, S, E); }
#endif
        SEAM();
#ifndef NO_PH_DN
        if (IN_PH()) { CArgs* A_ = ARGS(); unsigned char* ws = A_->ws + A_->ws_off; bf16* XB = (bf16*)(ws + WS_XB); bf16* H = (bf16*)(ws + WS_H); float* SSP = (float*)(ws + WS_SSP); (void)XB; (void)H; (void)SSP;
            pg8::Gemm g{H, (const bf16*)(ws + WS_WDN + s * SZ_WDN), M, D, FF}; pg8::StaticOrder S; S.init(M, D, G, (int)blockIdx.x);
            pg8::EpiResid<false> E{s == 0 ? A_->in[0] : nullptr, nullptr, XB, SSP, nullptr, 0.5f};
            pg8::gemm_phase<pg8::EpiResid<false>, pg8::StaticOrder, true, true>(lds, g, S, E); }
#endif
        SEAM();
        if (s == 0) {
#ifndef NO_PH_ABI
#pragma unroll 1
        for (int rep_ = 0; rep_ < ((PROBE_DUP & 4) ? 2 : 1); ++rep_)
            if (IN_PH()) { CArgs* A_ = ARGS(); unsigned char* ws = A_->ws + A_->ws_off; bf16* XB = (bf16*)(ws + WS_XB); bf16* H = (bf16*)(ws + WS_H); float* SSP = (float*)(ws + WS_SSP); (void)XB; (void)H; (void)SSP;
            pg8::Gemm g{XB, (const bf16*)(ws + WS_WABI), M, N_AB, D}; pg8::StaticOrder S; S.init(M, N_AB, G, (int)blockIdx.x);
                build_rstd_table(lds, SSP, S, tid);
                pg8::EpiAb E{H, lds};
                pg8::gemm_phase<pg8::EpiAb, pg8::StaticOrder, true, true>(lds, g, S, E); }
#endif
            SEAM();
#pragma unroll 1
            for (int rep_ = 0; rep_ < ((PROBE_DUP & 8) ? 2 : 1); ++rep_)
            if (IN_PH()) poolconv_phase(ARGS(), lds, G, tid, wave, lane);
            SEAM();
#ifndef NO_PH_ABO
            if (IN_PH()) { CArgs* A_ = ARGS(); unsigned char* ws = A_->ws + A_->ws_off; bf16* XB = (bf16*)(ws + WS_XB); bf16* H = (bf16*)(ws + WS_H); float* SSP = (float*)(ws + WS_SSP); (void)XB; (void)H; (void)SSP;
            pg8::Gemm g{(const bf16*)(ws + WS_A2), (const bf16*)(ws + WS_WABO), M, D, D}; pg8::StaticOrder S; S.init(M, D, G, (int)blockIdx.x);
                pg8::EpiResid<true> E{nullptr, nullptr, XB, SSP, (const float*)(ws + WS_BIAS2), 1.0f};
                pg8::gemm_phase<pg8::EpiResid<true>, pg8::StaticOrder, true, true>(lds, g, S, E); }
#endif
            SEAM();
        } else if (s == 2) {
#ifndef NO_PH_SGI
#pragma unroll 1
        for (int rep_ = 0; rep_ < ((PROBE_DUP & 4) ? 2 : 1); ++rep_)
            if (IN_PH()) { CArgs* A_ = ARGS(); unsigned char* ws = A_->ws + A_->ws_off; bf16* XB = (bf16*)(ws + WS_XB); bf16* H = (bf16*)(ws + WS_H); float* SSP = (float*)(ws + WS_SSP); (void)XB; (void)H; (void)SSP;
            pg8::Gemm g{XB, (const bf16*)(ws + WS_WSGI), M, N_SGU, D}; pg8::StaticOrder S; S.init(M, N_SGU, G, (int)blockIdx.x);
                build_rstd_table(lds, SSP, S, tid);
                pg8::EpiSgu E{H, lds, (pg8::f32x2*)(ws + WS_VST)};
                pg8::gemm_phase<pg8::EpiSgu, pg8::StaticOrder, true, true>(lds, g, S, E); }
#endif
            SEAM();
#pragma unroll 1
            for (int rep_ = 0; rep_ < ((PROBE_DUP & 16) ? 2 : 1); ++rep_)
            if (IN_PH()) sgu_phase(ARGS(), lds, G, tid, wave, lane);
            SEAM();
#ifndef NO_PH_SGO
            if (IN_PH()) { CArgs* A_ = ARGS(); unsigned char* ws = A_->ws + A_->ws_off; bf16* XB = (bf16*)(ws + WS_XB); bf16* H = (bf16*)(ws + WS_H); float* SSP = (float*)(ws + WS_SSP); (void)XB; (void)H; (void)SSP;
            pg8::Gemm g{(const bf16*)(ws + WS_A3), (const bf16*)(ws + WS_WSGO), M, D, D}; pg8::StaticOrder S; S.init(M, D, G, (int)blockIdx.x);
                pg8::EpiResid<false> E{nullptr, nullptr, XB, SSP, nullptr, 1.0f};
                pg8::gemm_phase<pg8::EpiResid<false>, pg8::StaticOrder, true, true>(lds, g, S, E); }
#endif
            SEAM();
        }
    }
    if (IN_PH()) final_phase(ARGS(), gw, NGW, lane);
#undef IN_PH
#undef ARGS
#undef WSP
#undef SEAM
}

extern "C" void kernel_launch(void* const* d_in, const int* in_sizes, int n_in, void* d_out, int out_size, void* d_ws, size_t ws_size, hipStream_t stream) {
    static int grid = 0;
    if (grid == 0) {
        if (n_in != 24 || in_sizes[0] != M * D || out_size != M * D || ws_size < WS_END) { fprintf(stderr, "kernel_launch: unexpected shapes (n_in %d, in0 %d, out %d, ws %zu < %zu)\n", n_in, n_in > 0 ? in_sizes[0] : -1, out_size, ws_size, (size_t)WS_END); grid = -1; return; }
        int dev = 0, cus = 0, per_cu = 0;
        if (hipGetDevice(&dev) != hipSuccess || hipDeviceGetAttribute(&cus, hipDeviceAttributeMultiprocessorCount, dev) != hipSuccess) { grid = -1; return; }
        if (hipOccupancyMaxActiveBlocksPerMultiprocessor(&per_cu, (const void*)mk_fwd, NTHR, 0) != hipSuccess || per_cu < 1) { fprintf(stderr, "kernel_launch: occupancy query says %d blocks per CU\n", per_cu); per_cu = 1; }
        (void)hipGetLastError();
        grid = cus * per_cu;
    }
    if (grid < 0) return;
    Args a{};
    for (int i = 0; i < 24; ++i) a.in[i] = (const float*)d_in[i];
    a.out = (float*)d_out; a.ws = (unsigned char*)d_ws; a.ws_off = (ws_size - WS_END) & ~(size_t)(2 * MiB - 1);
#if MK_PER_PHASE
    for (int p = 0; p < N_PHASES; ++p) { a.ph_lo = p; a.ph_hi = p + 1; hipLaunchKernelGGL(mk_fwd, dim3(grid), dim3(NTHR), 0, stream, a); }
#else
    a.ph_lo = 0; a.ph_hi = N_PHASES;
    if (hipMemsetAsync((char*)d_ws + a.ws_off + WS_CTL, 0, CTL_BYTES, stream) != hipSuccess) { fprintf(stderr, "kernel_launch: memset of the barrier words failed\n"); return; }
    void* kargs[] = {&a};
    hipError_t e = hipLaunchCooperativeKernel((const void*)mk_fwd, dim3(grid), dim3(NTHR), kargs, 0, stream);
    if (e != hipSuccess) fprintf(stderr, "kernel_launch: cooperative launch failed: %s (grid %d)\n", hipGetErrorString(e), grid);
#endif
}
```

```cpp
#include <hip/hip_runtime.h>
#include <hip/hip_cooperative_groups.h>
#include <cstdio>
#include <cstdint>
namespace pg8 {
#define PG8_LAS __attribute__((address_space(3)))
typedef unsigned short bf16_t;
typedef short bf16x8 __attribute__((ext_vector_type(8)));
typedef float f32x4 __attribute__((ext_vector_type(4)));
typedef unsigned u32x4 __attribute__((ext_vector_type(4)));
constexpr int BM = 256, BK = 64, HALF = 128, HTB = HALF * BK * 2  , STAGE_BYTES = 8 * HTB, NXCD = 8, WGM = 8;

__host__ __device__ __forceinline__ int lds_byte(int r, int c) { const int st = (r >> 4) * 2 + (c >> 5), rr = r & 15, cc = c & 31, ob = rr * 64 + cc * 2; return st * 1024 + (ob ^ (((ob >> 9) & 1) << 5)); }
__host__ __device__ __forceinline__ void stage_rc(int b, int& R, int& C) { const int st = b / 1024, sb = b % 1024, swz = sb ^ (((sb >> 9) & 1) << 5); R = (st >> 1) * 16 + swz / 64; C = (st & 1) * 32 + (swz % 64) / 2; }
__host__ __device__ __forceinline__ int perm32(int rho) { const int n = rho >> 4, i = rho & 15; return 8 * (i >> 2) + 4 * n + (i & 3); }

struct Unit { int pm, pn; };
struct Gemm { const bf16_t* A; const bf16_t* Bt; int M, N, K; };

struct StaticOrder {
    int nM, nN, nwg, G, c;
    __host__ __device__ void init(int M, int N, int G_, int c_) { nM = M / BM; nN = N / BM; nwg = nM * nN; G = G_; c = c_; }
    __host__ __device__ bool next(int i, Unit& u) const {
        const long L = (long)i * G + c; if (L >= nwg) return false;
        int wgid = (int)L; { const int q = nwg / NXCD, r = nwg % NXCD, xcd = wgid % NXCD, off = wgid / NXCD; wgid = (xcd < r ? xcd * (q + 1) : r * (q + 1) + (xcd - r) * q) + off; }
        const int nig = WGM * nN, gid = wgid / nig, fm = gid * WGM, gsz = (nM - fm) < WGM ? (nM - fm) : WGM;
        u.pm = fm + ((wgid % nig) % gsz); u.pn = (wgid % nig) / gsz; return true;
    }
    __device__ __forceinline__ void a_ready(const Unit&) const {}
    __device__ __forceinline__ void done(const Unit&) const {}
};

__device__ __forceinline__ unsigned cvt_pk_bf16(float lo, float hi) { unsigned r; asm volatile("v_cvt_pk_bf16_f32 %0, %1, %2" : "=v"(r) : "v"(lo), "v"(hi)); return r; }
typedef float f32x2 __attribute__((ext_vector_type(2)));
__device__ __forceinline__ f32x2 gelu_pk(f32x2 v) {
    const f32x2 av = __builtin_elementwise_abs(v), d = av * 0.2316418882f + 1.0f;
    f32x2 t; t.x = __builtin_amdgcn_rcpf(d.x); t.y = __builtin_amdgcn_rcpf(d.y);
    f32x2 q = t * 0.5307027145f + (-0.7265760135f); q = q * t + 0.7107068705f; q = q * t + (-0.142248368f); q = q * t + 0.127414796f; q = q * t;
    const f32x2 s = (v * v) * (-0.72134752044f);
    f32x2 e; e.x = __builtin_amdgcn_exp2f(s.x); e.y = __builtin_amdgcn_exp2f(s.y);
    const f32x2 m = v * (q * e), r = v - m;
    f32x2 o; o.x = v.x < 0.f ? m.x : r.x; o.y = v.y < 0.f ? m.y : r.y; return o;
}
constexpr float RMS_EPS = 1e-6f;
typedef unsigned u32x2 __attribute__((ext_vector_type(2)));
constexpr int RSTD_OFF = 131072 + 1024;
__device__ __forceinline__ float row_rstd(PG8_LAS unsigned char* lds, int ui, int r) { return *(const PG8_LAS float*)(lds + RSTD_OFF + (ui * 256 + r) * 4); }
__device__ __forceinline__ float silu_f(float x) { return x * __builtin_amdgcn_rcpf(1.0f + __builtin_amdgcn_exp2f(x * -1.44269504089f)); }
__device__ __forceinline__ float sigm_f(float x) { return __builtin_amdgcn_rcpf(1.0f + __builtin_amdgcn_exp2f(x * -1.44269504089f)); }
__device__ __forceinline__ u32x4 pack8(const f32x4& a, const f32x4& b) { u32x4 w; w.x = cvt_pk_bf16(a[0], a[1]); w.y = cvt_pk_bf16(a[2], a[3]); w.z = cvt_pk_bf16(b[0], b[1]); w.w = cvt_pk_bf16(b[2], b[3]); return w; }

struct EpiSwiglu {
    static constexpr bool PERM = true, AFTER_DRAIN = false;
    bf16_t* H; int ldh; PG8_LAS unsigned char* lds; int skip;
    __device__ __forceinline__ void operator()(const f32x4 (&acc)[2][2][4][2], const Unit& u, int ui, int wr, int wc, int fr, int fq) const {
        asm volatile("" : "+v"(fr), "+v"(fq));
        if (skip) return;
        const int row0 = u.pm * BM + wr * 64 + fr, col0 = u.pn * HALF + wc * 32 + 8 * fq;
        float rs[2][4];
#pragma unroll
        for (int ai = 0; ai < 2; ++ai)
#pragma unroll
            for (int m = 0; m < 4; ++m) rs[ai][m] = row_rstd(lds, ui, ai * HALF + wr * 64 + m * 16 + fr);
#pragma unroll
        for (int ai = 0; ai < 2; ++ai)
#pragma unroll
            for (int m = 0; m < 4; ++m) { const float r = rs[ai][m]; const int row = row0 + ai * HALF + m * 16;
                const float c1 = r * -1.44269504089f, r2 = r * r; u32x4 w;
#pragma unroll
                for (int n = 0; n < 2; ++n)
#pragma unroll
                    for (int p = 0; p < 2; ++p) { const f32x2 g = (f32x2){acc[ai][0][m][n][2 * p], acc[ai][0][m][n][2 * p + 1]}, uu = (f32x2){acc[ai][1][m][n][2 * p], acc[ai][1][m][n][2 * p + 1]};
                        const f32x2 t = g * c1; f32x2 d; d.x = __builtin_amdgcn_exp2f(t.x); d.y = __builtin_amdgcn_exp2f(t.y); d = d + 1.0f;
                        f32x2 q; q.x = __builtin_amdgcn_rcpf(d.x); q.y = __builtin_amdgcn_rcpf(d.y);
                        const f32x2 hh = (g * uu) * (q * r2); w[2 * n + p] = cvt_pk_bf16(hh.x, hh.y); }
                __builtin_nontemporal_store(w, (u32x4*)(H + (size_t)row * ldh + col0)); }
    }
};

template <bool HAS_BIAS> struct EpiResid {
    static constexpr bool PERM = true, AFTER_DRAIN = false;
    const float* basef; float* outf; bf16_t* xb; float* ssp; const float* bias; float alpha;
    __device__ __forceinline__ void operator()(const f32x4 (&acc)[2][2][4][2], const Unit& u, int ui, int wr, int wc, int fr, int fq) const {
        asm volatile("" : "+v"(fr), "+v"(fq));
        const int row0 = u.pm * BM + wr * 64 + fr, col0 = u.pn * BM + wc * 32 + 8 * fq;
        f32x4 bv[2][2];
#pragma unroll
        for (int bj = 0; bj < 2; ++bj)
#pragma unroll
            for (int n = 0; n < 2; ++n) bv[bj][n] = HAS_BIAS ? *(const f32x4*)(bias + col0 + bj * HALF + 4 * n) : (f32x4){0.f, 0.f, 0.f, 0.f};
#pragma unroll
        for (int ai = 0; ai < 2; ++ai)
#pragma unroll
            for (int m = 0; m < 4; ++m) { const int row = row0 + ai * HALF + m * 16; const size_t off = (size_t)row * 1024 + col0; float q = 0.f;
                f32x4 v[2][2];
                if (basef) {
#pragma unroll
                    for (int bj = 0; bj < 2; ++bj) { v[bj][0] = *(const f32x4*)(basef + off + bj * HALF); v[bj][1] = *(const f32x4*)(basef + off + bj * HALF + 4); }
                } else {
#pragma unroll
                    for (int bj = 0; bj < 2; ++bj) { const u32x4 raw = *(const u32x4*)(xb + off + bj * HALF);
                        v[bj][0] = (f32x4){__builtin_bit_cast(float, raw.x << 16), __builtin_bit_cast(float, raw.x & 0xffff0000u), __builtin_bit_cast(float, raw.y << 16), __builtin_bit_cast(float, raw.y & 0xffff0000u)};
                        v[bj][1] = (f32x4){__builtin_bit_cast(float, raw.z << 16), __builtin_bit_cast(float, raw.z & 0xffff0000u), __builtin_bit_cast(float, raw.w << 16), __builtin_bit_cast(float, raw.w & 0xffff0000u)}; }
                }
#pragma unroll
                for (int bj = 0; bj < 2; ++bj) {
                    f32x4 v0 = v[bj][0] + acc[ai][bj][m][0] * alpha, v1 = v[bj][1] + acc[ai][bj][m][1] * alpha;
                    if (HAS_BIAS) { v0 += bv[bj][0]; v1 += bv[bj][1]; }
                    if (outf) { *(f32x4*)(outf + off + bj * HALF) = v0; *(f32x4*)(outf + off + bj * HALF + 4) = v1; }
                    else *(u32x4*)(xb + off + bj * HALF) = pack8(v0, v1);
                    q += (v0[0] * v0[0] + v0[1] * v0[1]) + (v0[2] * v0[2] + v0[3] * v0[3]) + (v1[0] * v1[0] + v1[1] * v1[1]) + (v1[2] * v1[2] + v1[3] * v1[3]); }
                q += __shfl_xor(q, 16); q += __shfl_xor(q, 32);
                if (fq == 0) ssp[(size_t)row * 16 + u.pn * 4 + wc] = q;
                if (m == 3) asm volatile("" ::: "memory"); }
    }
};

struct EpiAb {
    static constexpr bool PERM = true, AFTER_DRAIN = false;
    bf16_t* UG; PG8_LAS unsigned char* lds;
    __device__ __forceinline__ void operator()(const f32x4 (&acc)[2][2][4][2], const Unit& u, int ui, int wr, int wc, int fr, int fq) const {
        asm volatile("" : "+v"(fr), "+v"(fq));
        const int row0 = u.pm * BM + wr * 64 + fr, cw = wc * 32 + 8 * fq;
        float rs[2][4];
#pragma unroll
        for (int ai = 0; ai < 2; ++ai)
#pragma unroll
            for (int m = 0; m < 4; ++m) rs[ai][m] = row_rstd(lds, ui, ai * HALF + wr * 64 + m * 16 + fr);
        if (u.pn < 2) {
#pragma unroll
            for (int ai = 0; ai < 2; ++ai)
#pragma unroll
                for (int m = 0; m < 4; ++m) { const float r = rs[ai][m]; bf16_t* rowp = UG + (size_t)(row0 + ai * HALF + m * 16) * 1024 + u.pn * BM + cw;
#pragma unroll
                    for (int bj = 0; bj < 2; ++bj) *(u32x4*)(rowp + bj * HALF) = pack8(acc[ai][bj][m][0] * r, acc[ai][bj][m][1] * r); }
        } else {
#pragma unroll
            for (int ai = 0; ai < 2; ++ai)
#pragma unroll
                for (int m = 0; m < 4; ++m) { const float r = rs[ai][m]; bf16_t* rowp = UG + (size_t)(row0 + ai * HALF + m * 16) * 1024 + 512 + (u.pn - 2) * HALF + cw;
                    const float c1 = r * -1.44269504089f; u32x4 w;
#pragma unroll
                    for (int n = 0; n < 2; ++n)
#pragma unroll
                        for (int p = 0; p < 2; ++p) { const f32x2 av = (f32x2){acc[ai][0][m][n][2 * p], acc[ai][0][m][n][2 * p + 1]}, gt = (f32x2){acc[ai][1][m][n][2 * p], acc[ai][1][m][n][2 * p + 1]};
                            const f32x2 t = gt * c1; f32x2 d; d.x = __builtin_amdgcn_exp2f(t.x); d.y = __builtin_amdgcn_exp2f(t.y); d = d + 1.0f;
                            f32x2 q; q.x = __builtin_amdgcn_rcpf(d.x); q.y = __builtin_amdgcn_rcpf(d.y);
                            const f32x2 hh = av * (q * r); w[2 * n + p] = cvt_pk_bf16(hh.x, hh.y); }
                    *(u32x4*)rowp = w; }
        }
    }
};

struct EpiSgu {
    static constexpr bool PERM = true, AFTER_DRAIN = false;
    bf16_t* Z; PG8_LAS unsigned char* lds; f32x2* vst;
    __device__ __forceinline__ void operator()(const f32x4 (&acc)[2][2][4][2], const Unit& u, int ui, int wr, int wc, int fr, int fq) const {
        asm volatile("" : "+v"(fr), "+v"(fq));
        const int row0 = u.pm * BM + wr * 64 + fr, col0 = u.pn * BM + wc * 32 + 8 * fq;
        float rs[2][4];
#pragma unroll
        for (int ai = 0; ai < 2; ++ai)
#pragma unroll
            for (int m = 0; m < 4; ++m) rs[ai][m] = row_rstd(lds, ui, ai * HALF + wr * 64 + m * 16 + fr);
#pragma unroll
        for (int ai = 0; ai < 2; ++ai)
#pragma unroll
            for (int m = 0; m < 4; ++m) { const float r = rs[ai][m]; const int row = row0 + ai * HALF + m * 16; bf16_t* rowp = Z + (size_t)row * 2048 + col0; float s1 = 0.f, s2 = 0.f;
#pragma unroll
                for (int bj = 0; bj < 2; ++bj) { const f32x4 v0 = acc[ai][bj][m][0] * r, v1 = acc[ai][bj][m][1] * r;
                    const f32x2 a = gelu_pk((f32x2){v0[0], v0[1]}), b = gelu_pk((f32x2){v0[2], v0[3]}), c = gelu_pk((f32x2){v1[0], v1[1]}), d = gelu_pk((f32x2){v1[2], v1[3]});
                    const f32x4 z0 = (f32x4){a.x, a.y, b.x, b.y}, z1 = (f32x4){c.x, c.y, d.x, d.y};
                    *(u32x4*)(rowp + bj * HALF) = pack8(z0, z1);
                    s1 += (z0[0] + z0[1]) + (z0[2] + z0[3]) + (z1[0] + z1[1]) + (z1[2] + z1[3]);
                    s2 += (z0[0] * z0[0] + z0[1] * z0[1]) + (z0[2] * z0[2] + z0[3] * z0[3]) + (z1[0] * z1[0] + z1[1] * z1[1]) + (z1[2] * z1[2] + z1[3] * z1[3]); }
                if (u.pn >= 4) { s1 += __shfl_xor(s1, 16); s1 += __shfl_xor(s1, 32); s2 += __shfl_xor(s2, 16); s2 += __shfl_xor(s2, 32);
                    if (fq == 0) vst[(size_t)row * 16 + (u.pn - 4) * 4 + wc] = (f32x2){s1, s2}; } }
    }
};


struct EpiNull {
    static constexpr bool PERM = true, AFTER_DRAIN = false;
    float* sink;
    __device__ __forceinline__ void operator()(const f32x4 (&acc)[2][2][4][2], const Unit& u, int ui, int wr, int wc, int fr, int fq) const {
        float s = 0.f;
#pragma unroll
        for (int ai = 0; ai < 2; ++ai)
#pragma unroll
            for (int bj = 0; bj < 2; ++bj)
#pragma unroll
                for (int m = 0; m < 4; ++m)
#pragma unroll
                    for (int n = 0; n < 2; ++n) s += acc[ai][bj][m][n][0] + acc[ai][bj][m][n][1] + acc[ai][bj][m][n][2] + acc[ai][bj][m][n][3];
        if (s == 1.2345678e30f) sink[0] = s;
    }
};
template <class Epi, class Sched, bool ALIGN_EPI = false, bool SP2 = false>
__device__ __forceinline__ void gemm_phase(PG8_LAS unsigned char* lds, const Gemm g, const Sched& S, const Epi& E) {
    int tid_ = threadIdx.x; asm volatile("" : "+v"(tid_));
    const int tid = tid_, wid = __builtin_amdgcn_readfirstlane(tid >> 6), lane = tid & 63, wr = wid >> 2, wc = wid & 3, fr = lane & 15, fq = lane >> 4;
    const int K = g.K, nt = K / BK;
    unsigned voffA[2], voffB[2];
#pragma unroll
    for (int i = 0; i < 2; ++i) { int R, C; stage_rc(tid * 16 + i * 8192, R, C); const int Rb = Epi::PERM ? ((R & ~31) + perm32(R & 31)) : R;
        voffA[i] = (unsigned)(R * K + C) * 2u; voffB[i] = (unsigned)(Rb * K + C) * 2u; }
    const size_t kstep = (size_t)(BK * 2);
    const size_t hstep = (size_t)HALF * K * 2;
    const size_t tstep = 2 * hstep;
    const unsigned ldsw = (unsigned)wid * 1024u;
    const int aoff = lds_byte(wr * 64 + fr, fq * 8), boff = lds_byte(wc * 32 + fr, fq * 8);
#define PG8_SA(b, h) (((b) * 2 + (h)) * HTB)
#define PG8_SB(b, h) ((4 + (b) * 2 + (h)) * HTB)
#define PG8_STAGE(bufoff, gbase, voff) do { _Pragma("unroll") for (int _i = 0; _i < 2; ++_i) \
        __builtin_amdgcn_global_load_lds((const unsigned*)((const char*)(gbase) + (voff)[_i]), (PG8_LAS unsigned*)(lds + (bufoff) + ldsw + _i * 8192), 16, 0, 0); } while (0)
#define PG8_LDA(dst, b, h) do { _Pragma("unroll") for (int m = 0; m < 4; ++m) _Pragma("unroll") for (int k = 0; k < 2; ++k) dst[m][k] = *(const PG8_LAS bf16x8*)(lds + PG8_SA(b, h) + aoff + m * 2048 + k * 1024); } while (0)
#define PG8_LDB(dst, b, h) do { _Pragma("unroll") for (int n = 0; n < 2; ++n) _Pragma("unroll") for (int k = 0; k < 2; ++k) dst[n][k] = *(const PG8_LAS bf16x8*)(lds + PG8_SB(b, h) + boff + n * 2048 + k * 1024); } while (0)
#define PG8_MMA(ai, bj, At, Bt) do { __builtin_amdgcn_s_setprio(1); _Pragma("unroll") for (int m = 0; m < 4; ++m) _Pragma("unroll") for (int n = 0; n < 2; ++n) _Pragma("unroll") for (int k = 0; k < 2; ++k) \
        acc[ai][bj][m][n] = __builtin_amdgcn_mfma_f32_16x16x32_bf16(Bt[n][k], At[m][k], acc[ai][bj][m][n], 0, 0, 0); __builtin_amdgcn_s_setprio(0); } while (0)
#define PG8_WAIT_V(n) asm volatile("s_waitcnt vmcnt(" #n ")" ::: "memory")
#define PG8_WAIT_L(n) asm volatile("s_waitcnt lgkmcnt(" #n ")" ::: "memory")
#define PG8_BAR __builtin_amdgcn_s_barrier()
#define PG8_SCHED __builtin_amdgcn_sched_barrier(0)
    Unit cur, nxt; int ui = 0;
    if (!S.next(0, cur)) return;
    f32x4 acc[2][2][4][2];
#pragma unroll
    for (int a = 0; a < 2; ++a)
#pragma unroll
        for (int b = 0; b < 2; ++b)
#pragma unroll
            for (int m = 0; m < 4; ++m)
#pragma unroll
                for (int n = 0; n < 2; ++n) acc[a][b][m][n] = (f32x4){0.f, 0.f, 0.f, 0.f};
    bf16x8 At[4][2], B0[2][2], B1[2][2];
    const char* cA = (const char*)g.A + (size_t)cur.pm * tstep; const char* cB = (const char*)g.Bt + (size_t)cur.pn * tstep;
    S.a_ready(cur);
    if constexpr (SP2) {
        PG8_STAGE(PG8_SB(0, 0), cB, voffB); PG8_STAGE(PG8_SB(0, 1), cB + hstep, voffB); PG8_STAGE(PG8_SA(0, 0), cA, voffA); PG8_STAGE(PG8_SA(0, 1), cA + hstep, voffA);
        if (wr == 1) PG8_BAR;
        PG8_WAIT_V(2); PG8_BAR;
        PG8_STAGE(PG8_SB(1, 0), cB + kstep, voffB); PG8_STAGE(PG8_SA(1, 0), cA + kstep, voffA); PG8_STAGE(PG8_SB(1, 1), cB + hstep + kstep, voffB);
        PG8_WAIT_V(6); PG8_BAR;
    } else {
        PG8_STAGE(PG8_SB(0, 0), cB, voffB); PG8_STAGE(PG8_SA(0, 0), cA, voffA); PG8_STAGE(PG8_SB(0, 1), cB + hstep, voffB); PG8_STAGE(PG8_SA(0, 1), cA + hstep, voffA);
        if (wr == 1) PG8_BAR;
        PG8_WAIT_V(4); PG8_BAR;
        PG8_STAGE(PG8_SB(1, 0), cB + kstep, voffB); PG8_STAGE(PG8_SA(1, 0), cA + kstep, voffA); PG8_STAGE(PG8_SB(1, 1), cB + hstep + kstep, voffB);
        PG8_WAIT_V(6); PG8_BAR;
    }
    for (;;) {
        const bool has_next = S.next(ui + 1, nxt);
        const char* nA = has_next ? (const char*)g.A + (size_t)nxt.pm * tstep : cA; const char* nB = has_next ? (const char*)g.Bt + (size_t)nxt.pn * tstep : cB;
        for (int t = 0; t < nt; t += 2) {
            const bool last = (t == nt - 2);
            const char* a1 = cA + (size_t)(t + 1) * kstep;
            const char* a2 = last ? nA : cA + (size_t)(t + 2) * kstep; const char* b2 = last ? nB : cB + (size_t)(t + 2) * kstep;
            const char* a3 = a2 + kstep; const char* b3 = b2 + kstep;
            if (last && has_next) S.a_ready(nxt);
            if constexpr (SP2) {
            PG8_LDB(B0, 0, 0); PG8_LDB(B1, 0, 1); PG8_SCHED; PG8_LDA(At, 0, 0); PG8_STAGE(PG8_SA(1, 1), a1 + hstep, voffA);
            PG8_WAIT_V(8); PG8_WAIT_L(0); PG8_BAR; PG8_MMA(0, 0, At, B0); PG8_MMA(0, 1, At, B1); PG8_BAR; PG8_SCHED;
            PG8_LDA(At, 0, 1); PG8_STAGE(PG8_SB(0, 0), b2, voffB); PG8_STAGE(PG8_SB(0, 1), b2 + hstep, voffB); PG8_STAGE(PG8_SA(0, 0), a2, voffA);
            PG8_WAIT_V(8); PG8_WAIT_L(0); PG8_BAR; PG8_MMA(1, 0, At, B0); PG8_MMA(1, 1, At, B1); PG8_BAR; PG8_SCHED;
            PG8_LDB(B0, 1, 0); PG8_LDB(B1, 1, 1); PG8_SCHED; PG8_LDA(At, 1, 0); PG8_STAGE(PG8_SA(0, 1), a2 + hstep, voffA);
            PG8_WAIT_V(8); PG8_WAIT_L(0); PG8_BAR; PG8_MMA(0, 0, At, B0); PG8_MMA(0, 1, At, B1); PG8_BAR; PG8_SCHED;
            PG8_LDA(At, 1, 1); PG8_STAGE(PG8_SB(1, 0), b3, voffB); PG8_STAGE(PG8_SB(1, 1), b3 + hstep, voffB); PG8_STAGE(PG8_SA(1, 0), a3, voffA);
            PG8_WAIT_V(8); PG8_WAIT_L(0); PG8_BAR; PG8_MMA(1, 0, At, B0); PG8_MMA(1, 1, At, B1); PG8_BAR; PG8_SCHED;
            } else {
            PG8_LDB(B0, 0, 0); PG8_SCHED; PG8_LDA(At, 0, 0); PG8_STAGE(PG8_SA(1, 1), a1 + hstep, voffA);
            PG8_WAIT_L(8); PG8_BAR; PG8_WAIT_L(0); PG8_MMA(0, 0, At, B0); PG8_BAR; PG8_SCHED;
            PG8_LDB(B1, 0, 1); PG8_STAGE(PG8_SB(0, 0), b2, voffB);
            PG8_BAR; PG8_WAIT_L(0); PG8_MMA(0, 1, At, B1); PG8_BAR;
            PG8_LDA(At, 0, 1); PG8_STAGE(PG8_SA(0, 0), a2, voffA);
            PG8_BAR; PG8_WAIT_L(0); PG8_MMA(1, 0, At, B0); PG8_BAR; PG8_SCHED;
            PG8_STAGE(PG8_SB(0, 1), b2 + hstep, voffB);
            PG8_WAIT_V(6); PG8_BAR; PG8_MMA(1, 1, At, B1); PG8_BAR;
            PG8_LDB(B0, 1, 0); PG8_SCHED; PG8_LDA(At, 1, 0); PG8_STAGE(PG8_SA(0, 1), a2 + hstep, voffA);
            PG8_WAIT_L(8); PG8_BAR; PG8_WAIT_L(0); PG8_MMA(0, 0, At, B0); PG8_BAR; PG8_SCHED;
            PG8_LDB(B1, 1, 1); PG8_STAGE(PG8_SB(1, 0), b3, voffB);
            PG8_BAR; PG8_WAIT_L(0); PG8_MMA(0, 1, At, B1); PG8_BAR;
            PG8_LDA(At, 1, 1); PG8_STAGE(PG8_SA(1, 0), a3, voffA);
            PG8_BAR; PG8_WAIT_L(0); PG8_MMA(1, 0, At, B0); PG8_BAR; PG8_SCHED;
            PG8_STAGE(PG8_SB(1, 1), b3 + hstep, voffB);
            PG8_WAIT_V(6); PG8_BAR; PG8_MMA(1, 1, At, B1); PG8_BAR;
            }
        }
        if constexpr (ALIGN_EPI) { if (wr == 0) PG8_BAR; }
        if constexpr (!Epi::AFTER_DRAIN) { E(acc, cur, ui, wr, wc, fr, fq); S.done(cur); }
        if (!has_next) break;
#pragma unroll
        for (int a = 0; a < 2; ++a)
#pragma unroll
            for (int b = 0; b < 2; ++b)
#pragma unroll
                for (int m = 0; m < 4; ++m)
#pragma unroll
                    for (int n = 0; n < 2; ++n) acc[a][b][m][n] = (f32x4){0.f, 0.f, 0.f, 0.f};
        cur = nxt; cA = nA; cB = nB; ++ui;
        if constexpr (ALIGN_EPI) { if (wr == 1) PG8_BAR; }
    }
    PG8_WAIT_V(0);
    if constexpr (!ALIGN_EPI) { if (wr == 0) PG8_BAR; }
    PG8_BAR;
    if constexpr (Epi::AFTER_DRAIN) { E.fused(acc, cur, wr, wc, fr, fq, lds, wid, lane); S.done(cur); }
#undef PG8_SA
#undef PG8_SB
#undef PG8_STAGE
#undef PG8_LDA
#undef PG8_LDB
#undef PG8_MMA
#undef PG8_WAIT_V
#undef PG8_WAIT_L
#undef PG8_BAR
#undef PG8_SCHED
}
}

namespace cg = cooperative_groups;
#define LAS __attribute__((address_space(3)))
typedef unsigned short bf16;
typedef unsigned v4u __attribute__((ext_vector_type(4)));
typedef unsigned v2u __attribute__((ext_vector_type(2)));
typedef float f32x4 __attribute__((ext_vector_type(4)));
typedef float f32x2 __attribute__((ext_vector_type(2)));
typedef short bf16x8 __attribute__((ext_vector_type(8)));

constexpr int NTHR = 512, NWAVES = 8;
constexpr int M = 32768, D = 1024, FF = 2816, SEQ = 8192;
constexpr int N_UP = 2 * FF, N_AB = 1536, N_SGU = 2048;
constexpr float EPS = 1e-6f;
constexpr int LDS_BYTES = 147456;
constexpr int N_PHASES = 16;

constexpr size_t MiB = 1u << 20;
constexpr size_t WS_H = 0;
constexpr size_t WS_A2 = WS_H + 64 * MiB, WS_A3 = WS_H + 128 * MiB;
constexpr size_t WS_WUP = 192 * MiB, SZ_WUP = (size_t)N_UP * D * 2;
constexpr size_t WS_WDN = WS_WUP + 4 * SZ_WUP, SZ_WDN = (size_t)D * FF * 2;
constexpr size_t WS_WABI = WS_WDN + 4 * SZ_WDN;
constexpr size_t WS_WABO = WS_WABI + (size_t)N_AB * D * 2;
constexpr size_t WS_WSGI = WS_WABO + (size_t)D * D * 2;
constexpr size_t WS_WSGO = WS_WSGI + (size_t)N_SGU * D * 2;
constexpr size_t WS_WM = WS_WSGO + (size_t)D * D * 2;
constexpr size_t WS_SSP = WS_WM + 1 * MiB;
constexpr size_t WS_VST = WS_SSP + (size_t)M * 16 * 4;
constexpr size_t WS_BIAS2 = WS_VST + (size_t)M * 16 * 8;
constexpr size_t WS_CTL = WS_BIAS2 + 1 * MiB, CTL_BYTES = 16384;
constexpr size_t WS_XB = WS_CTL + 1 * MiB;
constexpr size_t WS_END = WS_XB + 64 * MiB;

__device__ __forceinline__ unsigned f2bf(float f) { unsigned u = __builtin_bit_cast(unsigned, f); return (u + 0x7fffu + ((u >> 16) & 1u)) >> 16; }
__device__ __forceinline__ unsigned pk2(float lo, float hi) { return pg8::cvt_pk_bf16(lo, hi); }
__device__ __forceinline__ float bf2f(unsigned short h) { return __builtin_bit_cast(float, (unsigned)h << 16); }
#define LDS_WAIT() asm volatile("s_waitcnt lgkmcnt(0)" ::: "memory")

struct Args { const float* in[24]; float* out; unsigned char* ws; size_t ws_off; int ph_lo, ph_hi; };
typedef __attribute__((address_space(4))) const Args CArgs;

__device__ __forceinline__ void tr_item(const float* W, int N, bf16* WT, int ldt, int drow0, const float* gain, LAS float* scr, int k0, int n0, int lane) {
    float v[32];
#pragma unroll
    for (int i = 0; i < 32; ++i) { const int kk = 2 * i + (lane >> 5); v[i] = __builtin_nontemporal_load(&W[(size_t)(k0 + kk) * N + n0 + (lane & 31)]); }
#pragma unroll
    for (int i = 0; i < 32; ++i) { const int kk = 2 * i + (lane >> 5); scr[kk * 33 + (lane & 31)] = v[i]; }
    LDS_WAIT(); asm volatile("" ::: "memory");
    const int c = lane & 7;
    f32x4 g0 = (f32x4){1.f, 1.f, 1.f, 1.f}, g1 = g0;
    if (gain) { g0 = *(const f32x4*)(gain + k0 + 8 * c); g1 = *(const f32x4*)(gain + k0 + 8 * c + 4); }
#pragma unroll
    for (int j = 0; j < 4; ++j) { const int n = (lane >> 3) + 8 * j; const LAS float* s = scr + (8 * c) * 33 + n;
        v4u o; o.x = pk2(s[0 * 33] * g0[0], s[1 * 33] * g0[1]); o.y = pk2(s[2 * 33] * g0[2], s[3 * 33] * g0[3]); o.z = pk2(s[4 * 33] * g1[0], s[5 * 33] * g1[1]); o.w = pk2(s[6 * 33] * g1[2], s[7 * 33] * g1[3]);
        *(v4u*)(WT + (size_t)(drow0 + n) * ldt + k0 + 8 * c) = o; }
    LDS_WAIT(); asm volatile("" ::: "memory");
}
__device__ __forceinline__ int ilv_row(int n, int half) { const int hi = n >= half ? 1 : 0, nn = n - hi * half; return 256 * (nn >> 7) + 128 * hi + (nn & 127); }

__device__ __forceinline__ void prologue(CArgs* a, LAS unsigned char* lds, int gw, int NGW, int wave, int lane) {
    asm volatile("" : "+v"(lane));
    unsigned char* ws = a->ws + a->ws_off;
    LAS float* scr = (LAS float*)(lds + wave * 16384);
    constexpr int I_UP = (D / 64) * (N_UP / 32), I_DN = (FF / 64) * (D / 32), I_ABI = (D / 64) * (N_AB / 32), I_ABO = (512 / 64) * (D / 32), I_SGI = (D / 64) * (N_SGU / 32), I_SGO = (D / 64) * (D / 32);
    constexpr int NITEMS = 4 * I_UP + 4 * I_DN + I_ABI + I_ABO + I_SGI + I_SGO;
    for (int it = gw; it < NITEMS; it += NGW) {
        int r = it;
        if (r < 4 * I_UP) { const int s = r / I_UP, q = r % I_UP, l = s >> 1, f = s & 1; const int nblk = N_UP / 32, k0 = 64 * (q / nblk), n0 = 32 * (q % nblk);
            const float* W = (f ? a->in[6] : a->in[2]) + (size_t)l * D * N_UP; const float* g = (f ? a->in[5] : a->in[1]) + l * D;
            tr_item(W, N_UP, (bf16*)(ws + WS_WUP + s * SZ_WUP), D, ilv_row(n0, FF), g, scr, k0, n0, lane); continue; }
        r -= 4 * I_UP;
        if (r < 4 * I_DN) { const int s = r / I_DN, q = r % I_DN, l = s >> 1, f = s & 1; const int nblk = D / 32, k0 = 64 * (q / nblk), n0 = 32 * (q % nblk);
            const float* W = (f ? a->in[7] : a->in[3]) + (size_t)l * FF * D;
            tr_item(W, D, (bf16*)(ws + WS_WDN + s * SZ_WDN), FF, n0, nullptr, scr, k0, n0, lane); continue; }
        r -= 4 * I_DN;
        if (r < I_ABI) { const int nblk = N_AB / 32, k0 = 64 * (r / nblk), n0 = 32 * (r % nblk);
            const int drow = n0 < 512 ? n0 : 512 + ilv_row(n0 - 512, 512);
            tr_item(a->in[8], N_AB, (bf16*)(ws + WS_WABI), D, drow, a->in[4], scr, k0, n0, lane); continue; }
        r -= I_ABI;
        if (r < I_ABO) { const int nblk = D / 32, k0 = 512 + 64 * (r / nblk), n0 = 32 * (r % nblk);
            tr_item(a->in[16], D, (bf16*)(ws + WS_WABO), D, n0, nullptr, scr, k0, n0, lane); continue; }
        r -= I_ABO;
        if (r < I_SGI) { const int nblk = N_SGU / 32, k0 = 64 * (r / nblk), n0 = 32 * (r % nblk);
            tr_item(a->in[17], N_SGU, (bf16*)(ws + WS_WSGI), D, n0, a->in[4] + D, scr, k0, n0, lane); continue; }
        r -= I_SGI;
        { const int nblk = D / 32, k0 = 64 * (r / nblk), n0 = 32 * (r % nblk);
            tr_item(a->in[22], D, (bf16*)(ws + WS_WSGO), D, n0, nullptr, scr, k0, n0, lane); }
    }
    {   const float* pw = a->in[9]; const float* psc = a->in[11]; const float* wo = a->in[16]; bf16* WT = (bf16*)(ws + WS_WABO);
        for (int it = gw; it < 128 * 16; it += NGW) { const int k4 = it >> 4, nb = it & 15, g = k4 >> 5, kc0 = (k4 & 31) * 4, n = nb * 64 + lane;
            float acc[4] = {0.f, 0.f, 0.f, 0.f};
#pragma unroll 16
            for (int d = 0; d < 128; ++d) { const float wv = wo[(size_t)(g * 128 + d) * D + n] * psc[g * 128 + d];
#pragma unroll
                for (int i = 0; i < 4; ++i) acc[i] += pw[(size_t)((g * 128) + kc0 + i) * 128 + d] * wv; }
            v2u o; o.x = pk2(acc[0], acc[1]); o.y = pk2(acc[2], acc[3]);
            *(v2u*)(WT + (size_t)n * D + k4 * 4) = o; }
        const float* pb = a->in[10]; float* b2 = (float*)(ws + WS_BIAS2);
        for (int n = gw; n < D; n += NGW) { float s = 0.f;
#pragma unroll
            for (int j = 0; j < 8; ++j) { const int k = lane + 64 * j; s += pb[k] * psc[k] * wo[(size_t)k * D + n]; }
#pragma unroll
            for (int o = 1; o < 64; o <<= 1) s += __shfl_xor(s, o);
            if (lane == 0) b2[n] = s; }
    }
    {   const float* sw = a->in[20]; bf16* WM = (bf16*)(ws + WS_WM);
        for (int i = gw * 64 + lane; i < 8 * 128 * 128; i += NGW * 64) { const int s = (i >> 7) & 127, t = i & 127; WM[i] = (bf16)f2bf(t <= s ? sw[i] : 0.f); } }
    {   const float* x = a->in[0]; bf16* XB = (bf16*)(ws + WS_XB); float* ssp = (float*)(ws + WS_SSP);
        for (int mb = gw; mb < M; mb += 2 * NGW) { f32x4 v[2][4]; float s[2] = {0.f, 0.f};
#pragma unroll
            for (int rr = 0; rr < 2; ++rr) { const int m = mb + rr * NGW; if (m < M) { const f32x4* xr = (const f32x4*)(x + (size_t)m * D) + lane;
#pragma unroll
                for (int j = 0; j < 4; ++j) v[rr][j] = __builtin_nontemporal_load(&xr[64 * j]); } }
#pragma unroll
            for (int rr = 0; rr < 2; ++rr) { const int m = mb + rr * NGW; if (m < M) {
#pragma unroll
                for (int j = 0; j < 4; ++j) s[rr] += (v[rr][j][0] * v[rr][j][0] + v[rr][j][1] * v[rr][j][1]) + (v[rr][j][2] * v[rr][j][2] + v[rr][j][3] * v[rr][j][3]);
#pragma unroll
                for (int o = 1; o < 64; o <<= 1) s[rr] += __shfl_xor(s[rr], o);
                v2u* o8 = (v2u*)(XB + (size_t)m * D) + lane;
#pragma unroll
                for (int j = 0; j < 4; ++j) { v2u w; w.x = pk2(v[rr][j][0], v[rr][j][1]); w.y = pk2(v[rr][j][2], v[rr][j][3]); o8[64 * j] = w; }
                if (lane < 16) ssp[(size_t)m * 16 + lane] = lane == 0 ? s[rr] : 0.f; } } } }
}

__device__ __forceinline__ f32x2 bf2x2(unsigned w) { return (f32x2){__builtin_bit_cast(float, w << 16), __builtin_bit_cast(float, w & 0xffff0000u)}; }
__device__ __forceinline__ void pc_pass(int Q, const bf16* UG, bf16* A2, const float* cw, const float* cbias, LAS float* Yw, int mt, int ts, int lane) {
    asm volatile("" : "+v"(lane));
    const int c0 = 128 * Q + 2 * lane;
    f32x2 w[31]; unsigned graw[38], uraw[23];
#pragma unroll
    for (int i = 0; i < 38; ++i) { const int t = ts - 30 + i; graw[i] = (t >= 0) ? *(const unsigned*)(UG + (size_t)(mt - 30 + i) * 1024 + 512 + c0) : 0u; }
#pragma unroll
    for (int i = 0; i < 23; ++i) { const int t = ts - 15 + i; uraw[i] = (t >= 0) ? *(const unsigned*)(UG + (size_t)(mt - 15 + i) * 1024 + c0) : 0u; }
#pragma unroll
    for (int j = 0; j < 31; ++j) w[j] = *(const f32x2*)(cw + j * 512 + c0);
    const f32x2 cb = *(const f32x2*)(cbias + c0);
#define PC_POOL(WIN) do { _Pragma("unroll") for (int t = 0; t < 8; ++t) { const f32x2 ut = bf2x2(uraw[15 + t]); f32x2 s = ut; _Pragma("unroll") for (int j = 1; j < WIN; ++j) s += bf2x2(uraw[15 + t - j]); \
        const int cnt = min(ts + t + 1, WIN); const f32x2 p = s * __builtin_amdgcn_rcpf((float)cnt) - ut; *(unsigned*)(A2 + (size_t)(mt + t) * 1024 + c0) = pk2(p.x, p.y); } } while (0)
    if (Q == 0) PC_POOL(2); else if (Q == 1) PC_POOL(4); else if (Q == 2) PC_POOL(8); else PC_POOL(16);
#undef PC_POOL
    f32x2 y[8];
#pragma unroll
    for (int t = 0; t < 8; ++t) y[t] = cb;
#pragma unroll
    for (int i = 0; i < 38; ++i) { const f32x2 gv = bf2x2(graw[i]);
#pragma unroll
        for (int t = 0; t < 8; ++t) if (i - t >= 0 && i - t < 31) y[t] = __builtin_elementwise_fma(w[i - t], gv, y[t]); }
#pragma unroll
    for (int t = 0; t < 8; ++t) *(LAS f32x2*)(Yw + t * 512 + c0) = y[t];
}
__device__ __forceinline__ void poolconv_phase(CArgs* a, LAS unsigned char* lds, int G, int tid, int wave, int lane) {
    asm volatile("" : "+v"(tid), "+v"(lane));
    const bf16* UG = (const bf16*)(a->ws + a->ws_off + WS_H); bf16* A2 = (bf16*)(a->ws + a->ws_off + WS_A2);
    const float* cw = a->in[12]; const float* cbias = a->in[13];
    LAS float* Yw = (LAS float*)(lds + wave * 16384);
    const int c8 = 8 * lane;
    const f32x4 lg0 = *(const f32x4*)(a->in[14] + c8), lg1 = *(const f32x4*)(a->in[14] + c8 + 4), lb0 = *(const f32x4*)(a->in[15] + c8), lb1 = *(const f32x4*)(a->in[15] + c8 + 4);
    for (int unit = blockIdx.x; unit < M / 64; unit += G) {
        const int mt = unit * 64 + 8 * wave, ts = mt & (SEQ - 1);
#define PC_FENCE() do { asm volatile("" ::: "memory"); __builtin_amdgcn_sched_barrier(0); } while (0)
        _Pragma("unroll 1") for (int q = 0; q < 4; ++q) { pc_pass(q, UG, A2, cw, cbias, Yw, mt, ts, lane); PC_FENCE(); }
#undef PC_FENCE
#pragma unroll 2
        for (int t = 0; t < 8; ++t) { const LAS f32x4* yr = (const LAS f32x4*)(Yw + t * 512 + c8); const f32x4 p0 = yr[0], p1 = yr[1];
            float s1 = (p0[0] + p0[1]) + (p0[2] + p0[3]) + (p1[0] + p1[1]) + (p1[2] + p1[3]);
            float s2 = (p0[0] * p0[0] + p0[1] * p0[1]) + (p0[2] * p0[2] + p0[3] * p0[3]) + (p1[0] * p1[0] + p1[1] * p1[1]) + (p1[2] * p1[2] + p1[3] * p1[3]);
#pragma unroll
            for (int o = 1; o < 64; o <<= 1) { s1 += __shfl_xor(s1, o); s2 += __shfl_xor(s2, o); }
            const float mean = s1 * (1.f / 512.f), rs = __builtin_amdgcn_rsqf(s2 * (1.f / 512.f) - mean * mean + EPS);
            const f32x4 v0 = (p0 - mean) * rs * lg0 + lb0, v1 = (p1 - mean) * rs * lg1 + lb1;
            v4u o; o.x = pk2(pg8::silu_f(v0[0]), pg8::silu_f(v0[1])); o.y = pk2(pg8::silu_f(v0[2]), pg8::silu_f(v0[3])); o.z = pk2(pg8::silu_f(v1[0]), pg8::silu_f(v1[1])); o.w = pk2(pg8::silu_f(v1[2]), pg8::silu_f(v1[3]));
            *(v4u*)(A2 + (size_t)(mt + t) * 1024 + 512 + c8) = o; }
    }
}

typedef short s16x4 __attribute__((ext_vector_type(4)));
__device__ __forceinline__ void sgu_phase(CArgs* a, LAS unsigned char* lds, int G, int tid, int wave, int lane) {
    asm volatile("" : "+v"(tid), "+v"(lane));
    const bf16* Z = (const bf16*)(a->ws + a->ws_off + WS_H); bf16* A3 = (bf16*)(a->ws + a->ws_off + WS_A3); const f32x2* vst = (const f32x2*)(a->ws + a->ws_off + WS_VST); const bf16* WM = (const bf16*)(a->ws + a->ws_off + WS_WM);
    const float* lng = a->in[18]; const float* lnb = a->in[19]; const float* sb = a->in[21];
    constexpr int VS = 272;
    LAS unsigned char* VN = lds;
    LAS float* ST = (LAS float*)(lds + 36864);
    const int fr = lane & 15, fq = lane >> 4;
    const int c8 = (tid & 15) << 3, t0 = tid >> 4;
    const int troff = (8 * fq + (fr >> 2)) * VS + 8 * (lane & 3);
    const int nkk = (wave >> 1) + 1;
    for (int chunk = blockIdx.x; chunk < M / 128; chunk += G) {
        const int m0 = chunk * 128;
        if (tid < 128) { const f32x2* p = vst + (size_t)(m0 + tid) * 16; float s1 = 0.f, s2 = 0.f;
#pragma unroll
            for (int i = 0; i < 16; ++i) { const f32x2 q = p[i]; s1 += q.x; s2 += q.y; }
            const float mean = s1 * (1.f / 1024.f), var = s2 * (1.f / 1024.f) - mean * mean;
            ST[2 * tid] = mean; ST[2 * tid + 1] = __builtin_amdgcn_rsqf(var + EPS); }
        v4u x[4];
#pragma unroll
        for (int i = 0; i < 4; ++i) x[i] = __builtin_nontemporal_load((const v4u*)(Z + (size_t)(m0 + t0 + 32 * i) * 2048 + 1024 + c8));
        __syncthreads();
#pragma unroll 1
        for (int h = 0; h < 8; ++h) {
            {   const f32x4 g0 = *(const f32x4*)(lng + h * 128 + c8), g1 = *(const f32x4*)(lng + h * 128 + c8 + 4), b0 = *(const f32x4*)(lnb + h * 128 + c8), b1 = *(const f32x4*)(lnb + h * 128 + c8 + 4);
#pragma unroll
                for (int i = 0; i < 4; ++i) { const int t = t0 + 32 * i; const float mu = ST[2 * t], rs = ST[2 * t + 1];
                    const unsigned xs[4] = {x[i].x, x[i].y, x[i].z, x[i].w}; float lo[4], hi[4];
#pragma unroll
                    for (int e = 0; e < 4; ++e) { lo[e] = (__builtin_bit_cast(float, xs[e] << 16) - mu) * rs; hi[e] = (__builtin_bit_cast(float, xs[e] & 0xffff0000u) - mu) * rs; }
                    v4u o; o.x = pk2(lo[0] * g0[0] + b0[0], hi[0] * g0[1] + b0[1]); o.y = pk2(lo[1] * g0[2] + b0[2], hi[1] * g0[3] + b0[3]);
                    o.z = pk2(lo[2] * g1[0] + b1[0], hi[2] * g1[1] + b1[1]); o.w = pk2(lo[3] * g1[2] + b1[2], hi[3] * g1[3] + b1[3]);
                    *(LAS v4u*)(VN + t * VS + c8 * 2) = o; } }
            const int s = wave * 16 + fr; const size_t row = (size_t)(m0 + s);
            bf16x8 xfr[4];
#pragma unroll
            for (int kk = 0; kk < 4; ++kk) if (kk < nkk) xfr[kk] = *(const bf16x8*)(WM + (size_t)(h * 128 + s) * 128 + 32 * kk + 8 * fq);
            const float bs = sb[h * 128 + s];
            v2u uu[8];
#pragma unroll
            for (int cbk = 0; cbk < 8; ++cbk) uu[cbk] = __builtin_nontemporal_load((const v2u*)(Z + row * 2048 + h * 128 + 16 * cbk + 4 * fq));
            __syncthreads();
            if (h < 7) {
#pragma unroll
                for (int i = 0; i < 4; ++i) x[i] = __builtin_nontemporal_load((const v4u*)(Z + (size_t)(m0 + t0 + 32 * i) * 2048 + 1024 + (h + 1) * 128 + c8)); }
            f32x4 acc[8];
#pragma unroll
            for (int cbk = 0; cbk < 8; ++cbk) acc[cbk] = (f32x4){0.f, 0.f, 0.f, 0.f};
#pragma unroll
            for (int kk = 0; kk < 4; ++kk) if (kk < nkk) { const bf16x8 xf = xfr[kk];
#pragma unroll
                for (int cbk = 0; cbk < 8; ++cbk) {
                    const s16x4 p0 = __builtin_amdgcn_ds_read_tr16_b64_v4i16((LAS s16x4*)(VN + troff + (32 * kk) * VS + 32 * cbk));
                    const s16x4 p1 = __builtin_amdgcn_ds_read_tr16_b64_v4i16((LAS s16x4*)(VN + troff + (32 * kk + 4) * VS + 32 * cbk));
                    const bf16x8 yf = __builtin_shufflevector(p0, p1, 0, 1, 2, 3, 4, 5, 6, 7);
                    acc[cbk] = __builtin_amdgcn_mfma_f32_16x16x32_bf16(yf, xf, acc[cbk], 0, 0, 0); } }
#pragma unroll
            for (int cbk = 0; cbk < 8; ++cbk) { const int col = h * 128 + 16 * cbk + 4 * fq;
                const float u0 = __builtin_bit_cast(float, uu[cbk].x << 16), u1 = __builtin_bit_cast(float, uu[cbk].x & 0xffff0000u), u2 = __builtin_bit_cast(float, uu[cbk].y << 16), u3 = __builtin_bit_cast(float, uu[cbk].y & 0xffff0000u);
                v2u o; o.x = pk2(u0 * (acc[cbk][0] + bs), u1 * (acc[cbk][1] + bs)); o.y = pk2(u2 * (acc[cbk][2] + bs), u3 * (acc[cbk][3] + bs));
                *(v2u*)(A3 + row * 1024 + col) = o; }
            __syncthreads();
        }
    }
}

__device__ __forceinline__ void final_phase(CArgs* a, int gw, int NGW, int lane) {
    asm volatile("" : "+v"(lane));
    float* X = a->out; const bf16* XB = (const bf16*)(a->ws + a->ws_off + WS_XB); const float* ssp = (const float*)(a->ws + a->ws_off + WS_SSP); const float* g = a->in[23];
    for (int mb = gw; mb < M; mb += 2 * NGW) { v4u raw[2][2]; float sp[2];
#pragma unroll
        for (int rr = 0; rr < 2; ++rr) { const int m = mb + rr * NGW; if (m < M) { sp[rr] = ssp[(size_t)m * 16 + (lane & 15)];
#pragma unroll
            for (int j = 0; j < 2; ++j) raw[rr][j] = *((const v4u*)(XB + (size_t)m * D) + lane + 64 * j); } }
#pragma unroll
        for (int rr = 0; rr < 2; ++rr) { const int m = mb + rr * NGW; if (m < M) { float s = sp[rr];
            s += __shfl_xor(s, 1); s += __shfl_xor(s, 2); s += __shfl_xor(s, 4); s += __shfl_xor(s, 8);
            const float r = __builtin_amdgcn_rsqf(s * (1.f / 1024.f) + EPS);
#pragma unroll
            for (int j = 0; j < 2; ++j) { const v4u w = raw[rr][j]; const int col = 8 * (lane + 64 * j);
                const f32x4 g0 = *(const f32x4*)(g + col), g1 = *(const f32x4*)(g + col + 4);
                const f32x4 v0 = (f32x4){__builtin_bit_cast(float, w.x << 16), __builtin_bit_cast(float, w.x & 0xffff0000u), __builtin_bit_cast(float, w.y << 16), __builtin_bit_cast(float, w.y & 0xffff0000u)};
                const f32x4 v1 = (f32x4){__builtin_bit_cast(float, w.z << 16), __builtin_bit_cast(float, w.z & 0xffff0000u), __builtin_bit_cast(float, w.w << 16), __builtin_bit_cast(float, w.w & 0xffff0000u)};
                __builtin_nontemporal_store(v0 * r * g0, (f32x4*)(X + (size_t)m * D + col)); __builtin_nontemporal_store(v1 * r * g1, (f32x4*)(X + (size_t)m * D + col + 4)); } } } }
}

#define RLX_AGENT __ATOMIC_RELAXED, __HIP_MEMORY_SCOPE_AGENT
#define XB_TMO      128
#define XB_XCNT(j)  (256  + 64 * (j))
#define XB_XSUB(j)  (1280 + 64 * (j))
#define XB_XGEN(j)  (2304 + 64 * (j))
#define XB_TOP      3328
#define XB_TOPGEN   3392
#define XCD_BAR_WORDS 3456
#define XB_SPIN_CAP (1u << 18)

__device__ __forceinline__ unsigned xb_ld(unsigned* p)              { return __hip_atomic_load(p, __ATOMIC_RELAXED, __HIP_MEMORY_SCOPE_AGENT); }
__device__ __forceinline__ unsigned xb_add(unsigned* p, unsigned v) { return __hip_atomic_fetch_add(p, v, __ATOMIC_RELAXED, __HIP_MEMORY_SCOPE_AGENT); }
__device__ __forceinline__ unsigned xb_xcc_id() { return (unsigned)__builtin_amdgcn_s_getreg((3 << 11) | 20) & 0xFu; }
#define XB_SPIN(cond, bar) do { unsigned _sp = 0; while (cond) { __builtin_amdgcn_s_sleep(1); \
    if ((++_sp & 255u) == 0u) { if (xb_ld(&(bar)[XB_TMO])) break; if (_sp > XB_SPIN_CAP) { atomicAdd(&(bar)[XB_TMO], 1u); break; } } } } while (0)

struct XcdBarrier {
    unsigned* bar; unsigned x;
    volatile LAS unsigned* st;
};

__device__ __forceinline__ XcdBarrier xcd_barrier_post(unsigned* bar, volatile LAS unsigned* st) {
    XcdBarrier b; b.bar = bar; b.x = xb_xcc_id(); b.st = st;
    if (threadIdx.x == 0) (void)xb_add(&bar[XB_XCNT(b.x)], 1u);
    return b;
}
__device__ __forceinline__ void xcd_barrier_complete(unsigned* bar, unsigned x, unsigned& nloc, unsigned& nx) {
    const unsigned G = gridDim.x * gridDim.y * gridDim.z;
    unsigned sum, cnt, mine, sp = 0u;
    for (;;) {
        sum = 0u; cnt = 0u; mine = 0u;
#pragma unroll
        for (unsigned j = 0; j < 16; ++j) { const unsigned c = xb_ld(&bar[XB_XCNT(j)]); sum += c; cnt += (c > 0u) ? 1u : 0u; mine = (j == x) ? c : mine; }
        if (sum == G) break;
        __builtin_amdgcn_s_sleep(1);
        if ((++sp & 255u) == 0u) { if (xb_ld(&bar[XB_TMO])) break; if (sp > XB_SPIN_CAP) { atomicAdd(&bar[XB_TMO], 1u); break; } }
    }
    nloc = mine > 0u ? mine : 1u; nx = cnt > 0u ? cnt : 1u;
}

__device__ __forceinline__ void xcd_barrier(const XcdBarrier& b) {
    asm volatile("s_waitcnt vmcnt(0)" ::: "memory");
    __syncthreads();
    if (threadIdx.x == 0) {
        unsigned* bar = b.bar;
        __builtin_amdgcn_s_waitcnt(0);
        unsigned nloc = b.st[0], nx = b.st[1];
        if (nloc == 0u) { xcd_barrier_complete(bar, b.x, nloc, nx); b.st[0] = nloc; b.st[1] = nx; }
        const unsigned old = xb_add(&bar[XB_XSUB(b.x)], 1u);
        const unsigned gen = old / nloc;
        if (old + 1u == (gen + 1u) * nloc) {
            __builtin_amdgcn_fence(__ATOMIC_RELEASE, "agent");
            asm volatile("s_waitcnt vmcnt(0)" ::: "memory");
            const unsigned og = xb_add(&bar[XB_TOP], 1u);
            const unsigned tg = og / nx;
            if (og + 1u == (tg + 1u) * nx) xb_add(&bar[XB_TOPGEN], 1u);
            else XB_SPIN(xb_ld(&bar[XB_TOPGEN]) == tg, bar);
            __builtin_amdgcn_fence(__ATOMIC_ACQUIRE, "agent");
            xb_add(&bar[XB_XGEN(b.x)], 1u);
            asm volatile("s_waitcnt vmcnt(0)" ::: "memory");
        } else {
            XB_SPIN(xb_ld(&bar[XB_XGEN(b.x)]) == gen, bar);
            __builtin_amdgcn_fence(__ATOMIC_ACQUIRE, "agent");
            asm volatile("s_waitcnt vmcnt(0)" ::: "memory");
        }
    }
    __syncthreads();
}

__device__ __forceinline__ void build_rstd_table(LAS unsigned char* lds, const float* ssp, const pg8::StaticOrder& S, int tid) {
    asm volatile("" : "+v"(tid));
    f32x4 p[6][4]; bool ok[6];
#pragma unroll
    for (int k = 0; k < 6; ++k) { pg8::Unit u; ok[k] = S.next((tid >> 8) + 2 * k, u);
        if (ok[k]) { const f32x4* q = (const f32x4*)(ssp + (size_t)(u.pm * 256 + (tid & 255)) * 16);
#pragma unroll
            for (int j = 0; j < 4; ++j) p[k][j] = q[j]; } }
#pragma unroll
    for (int k = 0; k < 6; ++k) if (ok[k]) { float s = 0.f;
#pragma unroll
        for (int j = 0; j < 4; ++j) s += (p[k][j][0] + p[k][j][1]) + (p[k][j][2] + p[k][j][3]);
        *(LAS float*)(lds + pg8::RSTD_OFF + (((tid >> 8) + 2 * k) * 256 + (tid & 255)) * 4) = __builtin_amdgcn_rsqf(s * (1.0f / 1024.0f) + EPS); }
    __syncthreads();
}
#ifndef MK_PER_PHASE
#define MK_PER_PHASE 0
#endif
#ifndef PROBE_DUP
#define PROBE_DUP 0
#endif
__global__ void __launch_bounds__(NTHR) mk_fwd(Args args) {
    __shared__ __attribute__((aligned(16))) unsigned char lds_raw[LDS_BYTES];
    LAS unsigned char* lds = (LAS unsigned char*)lds_raw;
    cg::grid_group grid = cg::this_grid();
    const int tid = threadIdx.x, lane = tid & 63, wave = __builtin_amdgcn_readfirstlane(tid >> 6);
    const int G = gridDim.x, gw = blockIdx.x * NWAVES + wave, NGW = G * NWAVES;
    CArgs* ap = (CArgs*)__builtin_amdgcn_kernarg_segment_ptr();
#define ARGS() ({ CArgs* p_ = ap; asm volatile("" : "+s"(p_)); p_; })
#define WSP(off) (ARGS()->ws + (off))
#if MK_PER_PHASE
    const int lo = ap->ph_lo, hi = ap->ph_hi;
#else
    constexpr int lo = 0, hi = N_PHASES;
#endif
    int ph = 0;
#define MISCP ((volatile LAS unsigned*)(lds + 131072 + 320))
    if (tid < 32) MISCP[tid] = 0u;
    __syncthreads();
    if (hi - lo > 1) (void)xcd_barrier_post((unsigned*)(ap->ws + ap->ws_off + WS_CTL), MISCP + 8);
#define IN_PH() (lo <= ph && ph < hi)
#define SEAM() do { if (lo <= ph && ph + 1 < hi) { if (ap->ph_hi < 0) grid.sync();     { XcdBarrier b_; { CArgs* q_ = ARGS(); b_.bar = (unsigned*)(q_->ws + q_->ws_off + WS_CTL); } b_.x = xb_xcc_id(); b_.st = MISCP + 8; xcd_barrier(b_); } } ++ph; } while (0)

#pragma unroll 1
    for (int rep_ = 0; rep_ < ((PROBE_DUP & 1) ? 2 : 1); ++rep_)
    if (IN_PH()) prologue(ARGS(), lds, gw, NGW, wave, lane);
    SEAM();
#pragma unroll 1
    for (int s = 0; s < 4; ++s) {
#ifndef NO_PH_UP
#pragma unroll 1
        for (int rep_ = 0; rep_ < ((PROBE_DUP & (2 | 32)) ? 2 : 1); ++rep_)
        if (IN_PH()) { CArgs* A_ = ARGS(); unsigned char* ws = A_->ws + A_->ws_off; bf16* XB = (bf16*)(ws + WS_XB); bf16* H = (bf16*)(ws + WS_H); float* SSP = (float*)(ws + WS_SSP); (void)XB; (void)H; (void)SSP;
            pg8::Gemm g{XB, (const bf16*)(ws + WS_WUP + s * SZ_WUP), M, N_UP, D}; pg8::StaticOrder S; S.init(M, N_UP, G, (int)blockIdx.x);
            build_rstd_table(lds, SSP, S, tid);
            pg8::EpiSwiglu E{H, FF, lds, (PROBE_DUP & 32) ? rep_ : 0};
            pg8::gemm_phase<pg8::EpiSwiglu, pg8::StaticOrder, true, true>(lds, g, S, E); }
#endif
        SEAM();
#ifndef NO_PH_DN
        if (IN_PH()) { CArgs* A_ = ARGS(); unsigned char* ws = A_->ws + A_->ws_off; bf16* XB = (bf16*)(ws + WS_XB); bf16* H = (bf16*)(ws + WS_H); float* SSP = (float*)(ws + WS_SSP); (void)XB; (void)H; (void)SSP;
            pg8::Gemm g{H, (const bf16*)(ws + WS_WDN + s * SZ_WDN), M, D, FF}; pg8::StaticOrder S; S.init(M, D, G, (int)blockIdx.x);
            pg8::EpiResid<false> E{s == 0 ? A_->in[0] : nullptr, nullptr, XB, SSP, nullptr, 0.5f};
            pg8::gemm_phase<pg8::EpiResid<false>, pg8::StaticOrder, true, true>(lds, g, S, E); }
#endif
        SEAM();
        if (s == 0) {
#ifndef NO_PH_ABI
#pragma unroll 1
        for (int rep_ = 0; rep_ < ((PROBE_DUP & 4) ? 2 : 1); ++rep_)
            if (IN_PH()) { CArgs* A_ = ARGS(); unsigned char* ws = A_->ws + A_->ws_off; bf16* XB = (bf16*)(ws + WS_XB); bf16* H = (bf16*)(ws + WS_H); float* SSP = (float*)(ws + WS_SSP); (void)XB; (void)H; (void)SSP;
            pg8::Gemm g{XB, (const bf16*)(ws + WS_WABI), M, N_AB, D}; pg8::StaticOrder S; S.init(M, N_AB, G, (int)blockIdx.x);
                build_rstd_table(lds, SSP, S, tid);
                pg8::EpiAb E{H, lds};
                pg8::gemm_phase<pg8::EpiAb, pg8::StaticOrder, true, true>(lds, g, S, E); }
#endif
            SEAM();
#pragma unroll 1
            for (int rep_ = 0; rep_ < ((PROBE_DUP & 8) ? 2 : 1); ++rep_)
            if (IN_PH()) poolconv_phase(ARGS(), lds, G, tid, wave, lane);
            SEAM();
#ifndef NO_PH_ABO
            if (IN_PH()) { CArgs* A_ = ARGS(); unsigned char* ws = A_->ws + A_->ws_off; bf16* XB = (bf16*)(ws + WS_XB); bf16* H = (bf16*)(ws + WS_H); float* SSP = (float*)(ws + WS_SSP); (void)XB; (void)H; (void)SSP;
            pg8::Gemm g{(const bf16*)(ws + WS_A2), (const bf16*)(ws + WS_WABO), M, D, D}; pg8::StaticOrder S; S.init(M, D, G, (int)blockIdx.x);
                pg8::EpiResid<true> E{nullptr, nullptr, XB, SSP, (const float*)(ws + WS_BIAS2), 1.0f};
                pg8::gemm_phase<pg8::EpiResid<true>, pg8::StaticOrder, true, true>(lds, g, S, E); }
#endif
            SEAM();
        } else if (s == 2) {
#ifndef NO_PH_SGI
#pragma unroll 1
        for (int rep_ = 0; rep_ < ((PROBE_DUP & 4) ? 2 : 1); ++rep_)
            if (IN_PH()) { CArgs* A_ = ARGS(); unsigned char* ws = A_->ws + A_->ws_off; bf16* XB = (bf16*)(ws + WS_XB); bf16* H = (bf16*)(ws + WS_H); float* SSP = (float*)(ws + WS_SSP); (void)XB; (void)H; (void)SSP;
            pg8::Gemm g{XB, (const bf16*)(ws + WS_WSGI), M, N_SGU, D}; pg8::StaticOrder S; S.init(M, N_SGU, G, (int)blockIdx.x);
                build_rstd_table(lds, SSP, S, tid);
                pg8::EpiSgu E{H, lds, (pg8::f32x2*)(ws + WS_VST)};
                pg8::gemm_phase<pg8::EpiSgu, pg8::StaticOrder, true, true>(lds, g, S, E); }
#endif
            SEAM();
#pragma unroll 1
            for (int rep_ = 0; rep_ < ((PROBE_DUP & 16) ? 2 : 1); ++rep_)
            if (IN_PH()) sgu_phase(ARGS(), lds, G, tid, wave, lane);
            SEAM();
#ifndef NO_PH_SGO
            if (IN_PH()) { CArgs* A_ = ARGS(); unsigned char* ws = A_->ws + A_->ws_off; bf16* XB = (bf16*)(ws + WS_XB); bf16* H = (bf16*)(ws + WS_H); float* SSP = (float*)(ws + WS_SSP); (void)XB; (void)H; (void)SSP;
            pg8::Gemm g{(const bf16*)(ws + WS_A3), (const bf16*)(ws + WS_WSGO), M, D, D}; pg8::StaticOrder S; S.init(M, D, G, (int)blockIdx.x);
                pg8::EpiResid<false> E{nullptr, nullptr, XB, SSP, nullptr, 1.0f};
                pg8::gemm_phase<pg8::EpiResid<false>, pg8::StaticOrder, true, true>(lds, g, S, E); }
#endif
            SEAM();
        }
    }
    if (IN_PH()) final_phase(ARGS(), gw, NGW, lane);
#undef IN_PH
#undef ARGS
#undef WSP
#undef SEAM
}

extern "C" void kernel_launch(void* const* d_in, const int* in_sizes, int n_in, void* d_out, int out_size, void* d_ws, size_t ws_size, hipStream_t stream) {
    static int grid = 0;
    if (grid == 0) {
        if (n_in != 24 || in_sizes[0] != M * D || out_size != M * D || ws_size < WS_END) { fprintf(stderr, "kernel_launch: unexpected shapes (n_in %d, in0 %d, out %d, ws %zu < %zu)\n", n_in, n_in > 0 ? in_sizes[0] : -1, out_size, ws_size, (size_t)WS_END); grid = -1; return; }
        int dev = 0, cus = 0, per_cu = 0;
        if (hipGetDevice(&dev) != hipSuccess || hipDeviceGetAttribute(&cus, hipDeviceAttributeMultiprocessorCount, dev) != hipSuccess) { grid = -1; return; }
        if (hipOccupancyMaxActiveBlocksPerMultiprocessor(&per_cu, (const void*)mk_fwd, NTHR, 0) != hipSuccess || per_cu < 1) { fprintf(stderr, "kernel_launch: occupancy query says %d blocks per CU\n", per_cu); per_cu = 1; }
        (void)hipGetLastError();
        grid = cus * per_cu;
    }
    if (grid < 0) return;
    Args a{};
    for (int i = 0; i < 24; ++i) a.in[i] = (const float*)d_in[i];
    a.out = (float*)d_out; a.ws = (unsigned char*)d_ws; a.ws_off = (ws_size - WS_END) & ~(size_t)(2 * MiB - 1);
#if MK_PER_PHASE
    for (int p = 0; p < N_PHASES; ++p) { a.ph_lo = p; a.ph_hi = p + 1; hipLaunchKernelGGL(mk_fwd, dim3(grid), dim3(NTHR), 0, stream, a); }
#else
    a.ph_lo = 0; a.ph_hi = N_PHASES;
    if (hipMemsetAsync((char*)d_ws + a.ws_off + WS_CTL, 0, CTL_BYTES, stream) != hipSuccess) { fprintf(stderr, "kernel_launch: memset of the barrier words failed\n"); return; }
    void* kargs[] = {&a};
    hipError_t e = hipLaunchCooperativeKernel((const void*)mk_fwd, dim3(grid), dim3(NTHR), kargs, 0, stream);
    if (e != hipSuccess) fprintf(stderr, "kernel_launch: cooperative launch failed: %s (grid %d)\n", hipGetErrorString(e), grid);
#endif
}
```
